# Optimizing an MI355X kernel written in HIP

```python
import jax, jax.numpy as jnp
from jax import lax
import numpy as np

D_MODEL = 2048
BATCH = 4
SEQ = 4096
DEPTH = 1

PLE_DIM = 256
ATT_HEADS = 16
ATT_HD = 64
ATT_W = ATT_HEADS * ATT_HD
ROT_DIM = ATT_HD // 4
ROPE_THETA = 500000.0
DILATION_CFG = ((128, 1), (512, 4), (2048, 16))
HG_HEADS = 8
HG_DK = 128
HG_DV = 128
HG_W = HG_HEADS * HG_DV
HG_F = HG_HEADS * HG_DK
HG_CHUNK = 64
MIX_W = ATT_W + HG_W
SPLITS = (ATT_W, ATT_W, ATT_W, ATT_W,
          HG_F, HG_F, HG_F, HG_W, HG_W)
IN_W = sum(SPLITS)
SPLIT_IDX = [int(i) for i in np.cumsum(SPLITS)[:-1]]
EPS = 1e-6
NEG = -1e30

kernel_name = 'hybrid_dilated_attn_hgrn2_parallel_block'


def rmsnorm(x, g):
    xf = x.astype(jnp.float32)
    y = xf * lax.rsqrt(jnp.mean(xf * xf, axis=-1, keepdims=True) + EPS)
    return (y * g.astype(jnp.float32)).astype(x.dtype)


def rope_partial(x, pos):
    inv = jnp.power(ROPE_THETA, -jnp.arange(0, ROT_DIM, 2, dtype=jnp.float32) / ROT_DIM)
    ang = pos.astype(jnp.float32)[..., None] * inv
    c = jnp.cos(ang)[:, :, None, :]
    s = jnp.sin(ang)[:, :, None, :]
    x1 = x[..., :ROT_DIM // 2]
    x2 = x[..., ROT_DIM // 2:ROT_DIM]
    return jnp.concatenate([x1 * c - x2 * s, x2 * c + x1 * s, x[..., ROT_DIM:]], axis=-1)


def dilated_band_attention(q, k, v, window, dilation):
    B, S, H, E = q.shape
    half = (window // 2) // dilation
    blk = half
    L = S // dilation
    nb = -(-L // blk)
    Lp = nb * blk

    def strided(t):
        t = t.reshape(B, L, dilation, H, E).transpose(0, 2, 3, 1, 4)
        return jnp.pad(t, ((0, 0), (0, 0), (0, 0), (0, Lp - L), (0, 0)))

    def neighbours(t):
        tp = jnp.pad(t, ((0, 0), (0, 0), (0, 0), (blk, blk), (0, 0)))
        parts = [tp[:, :, :, j * blk:j * blk + Lp].reshape(B, dilation, H, nb, blk, E) for j in range(3)]
        return jnp.concatenate(parts, axis=4)

    qb = strided(q).reshape(B, dilation, H, nb, blk, E)
    kb = neighbours(strided(k))
    vb = neighbours(strided(v))
    qa = jnp.arange(nb)[:, None] * blk + jnp.arange(blk)[None, :]
    ka = jnp.arange(nb)[:, None] * blk - blk + jnp.arange(3 * blk)[None, :]
    rel = ka[:, None, :] - qa[:, :, None]
    valid = (jnp.abs(rel) <= half) & (ka[:, None, :] >= 0) & (ka[:, None, :] < L)
    s = jnp.einsum('bdhnqe,bdhnke->bdhnqk', qb, kb)
    s = jnp.where(valid, s, NEG)
    m = jnp.max(s, axis=-1, keepdims=True)
    pe = jnp.exp(s - m)
    den = jnp.sum(pe, axis=-1)
    o = jnp.einsum('bdhnqk,bdhnke->bdhnqe', pe, vb) / den[..., None]
    lse = m[..., 0] + jnp.log(den)
    o = o.reshape(B, dilation, H, Lp, E)[:, :, :, :L].transpose(0, 3, 1, 2, 4).reshape(B, S, H, E)
    lse = lse.reshape(B, dilation, H, Lp)[:, :, :, :L].transpose(0, 3, 1, 2).reshape(B, S, H)
    return o, lse


def hgrn2_chunk_scan(q, k, v, g):
    B, S, H, K = q.shape
    V = v.shape[-1]
    C = HG_CHUNK
    N = S // C

    def chunks(t):
        return t.reshape(B, N, C, H, t.shape[-1]).transpose(1, 0, 3, 2, 4)

    tri = jnp.tril(jnp.ones((C, C), dtype=bool))

    def step(state, inp):
        qc, kc, vc, gc = inp
        b = jnp.cumsum(gc, axis=2)
        diff = b[:, :, :, None, :] - b[:, :, None, :, :]
        decay = jnp.exp(jnp.where(tri[:, :, None], diff, -jnp.inf))
        att = jnp.einsum('bhtk,bhsk,bhtsk->bhts', qc, kc, decay)
        o = (jnp.einsum('bhts,bhsv->bhtv', att, vc)
             + jnp.einsum('bhtk,bhkv->bhtv', qc * jnp.exp(b), state))
        b_last = b[:, :, -1:, :]
        state = (jnp.exp(b_last[:, :, 0, :])[..., None] * state
                 + jnp.einsum('bhsk,bhsv->bhkv', kc * jnp.exp(b_last - b), vc))
        return state, o

    s0 = jnp.zeros((B, H, K, V), dtype=q.dtype)
    _, o = lax.scan(step, s0, (chunks(q), chunks(k), chunks(v), chunks(g)))
    return o.transpose(1, 0, 3, 2, 4).reshape(B, S, H, V)


def hgrn2_direction(qh, vh, f_logit, lb):
    f = lb + (1.0 - lb) * jax.nn.sigmoid(f_logit)
    return hgrn2_chunk_scan(qh, 1.0 - f, vh, jnp.log(f))


def hybrid_layer(h, p_l, pos, w_in, w_out, g_pre, g_post, g_hg, lb_f, lb_b, w_pg, w_pp, g_ple):
    B, S, _ = h.shape
    f32 = jnp.float32
    u = rmsnorm(h, g_pre)
    z = u @ w_in
    aq, ak, av, ag, hq, hf_f, hf_b, hv, hg = jnp.split(z, SPLIT_IDX, axis=-1)

    def heads(t, n):
        return t.reshape(B, S, n, -1).astype(f32)

    q = rope_partial(heads(aq, ATT_HEADS), pos) * (ATT_HD ** -0.5)
    k = rope_partial(heads(ak, ATT_HEADS), pos)
    v = heads(av, ATT_HEADS)
    res = [dilated_band_attention(q, k, v, w, d) for (w, d) in DILATION_CFG]
    outs = jnp.stack([r[0] for r in res])
    lses = jnp.stack([r[1] for r in res])
    alpha = jax.nn.softmax(lses, axis=0)
    o_att = jnp.einsum('gbsh,gbshe->bshe', alpha, outs).reshape(B, S, ATT_W)
    y_att = o_att * jax.nn.silu(ag.astype(f32))

    qh = jax.nn.silu(heads(hq, HG_HEADS))
    vh = heads(hv, HG_HEADS)
    o_fw = hgrn2_direction(qh, vh, heads(hf_f, HG_HEADS), lb_f)
    o_bw = jnp.flip(hgrn2_direction(jnp.flip(qh, 1), jnp.flip(vh, 1),
                                    jnp.flip(heads(hf_b, HG_HEADS), 1), lb_b), 1)
    o_hg = rmsnorm(o_fw + o_bw, g_hg).reshape(B, S, HG_W)
    y_hg = o_hg * jax.nn.silu(hg.astype(f32))

    y = jnp.concatenate([y_att, y_hg], axis=-1).astype(h.dtype) @ w_out
    h = h + rmsnorm(y, g_post)

    gate = jax.nn.sigmoid((h @ w_pg).astype(f32))
    e = (p_l @ w_pp).astype(f32)
    h = h + rmsnorm((gate * e).astype(h.dtype), g_ple)
    return h


def setup_inputs(seed: int = 0) -> dict:
    key = jax.random.key(seed)
    ks = jax.random.split(key, 16)
    nrm = jax.random.normal
    x = nrm(ks[0], (BATCH, SEQ, D_MODEL), jnp.float32)
    p = nrm(ks[1], (DEPTH, BATCH, SEQ, PLE_DIM), jnp.float32)
    positions = (jnp.arange(SEQ, dtype=jnp.int32)[None, :]
                 + jax.random.randint(ks[2], (BATCH, 1), 0, 1024, dtype=jnp.int32))
    w_in = nrm(ks[3], (DEPTH, D_MODEL, IN_W), jnp.float32) * D_MODEL ** -0.5
    w_out = nrm(ks[4], (DEPTH, MIX_W, D_MODEL), jnp.float32) * MIX_W ** -0.5
    g_pre = 1.0 + 0.05 * nrm(ks[5], (DEPTH, D_MODEL), jnp.float32)
    g_post = 1.0 + 0.05 * nrm(ks[6], (DEPTH, D_MODEL), jnp.float32)
    g_hg = 1.0 + 0.05 * nrm(ks[7], (DEPTH, HG_DV), jnp.float32)
    lb_fwd = 0.1 * nrm(ks[8], (DEPTH + 1, HG_F), jnp.float32)
    lb_bwd = 0.1 * nrm(ks[9], (DEPTH + 1, HG_F), jnp.float32)
    w_pg = nrm(ks[10], (DEPTH, D_MODEL, D_MODEL), jnp.float32) * D_MODEL ** -0.5
    w_pp = nrm(ks[11], (DEPTH, PLE_DIM, D_MODEL), jnp.float32) * PLE_DIM ** -0.5
    g_ple = 1.0 + 0.05 * nrm(ks[12], (DEPTH, D_MODEL), jnp.float32)
    return {'x': x, 'p': p, 'positions': positions, 'w_in': w_in, 'w_out': w_out,
            'g_pre': g_pre, 'g_post': g_post, 'g_hg': g_hg, 'lb_fwd': lb_fwd, 'lb_bwd': lb_bwd,
            'w_pg': w_pg, 'w_pp': w_pp, 'g_ple': g_ple}


def reference(x, p, positions, w_in, w_out, g_pre, g_post, g_hg, lb_fwd, lb_bwd, w_pg, w_pp, g_ple):
    lb_f_all = jnp.cumsum(jax.nn.softmax(lb_fwd.astype(jnp.float32), axis=0), axis=0)
    lb_b_all = jnp.cumsum(jax.nn.softmax(lb_bwd.astype(jnp.float32), axis=0), axis=0)
    h = x
    for i in range(DEPTH):
        h = hybrid_layer(h, p[i], positions, w_in[i], w_out[i], g_pre[i], g_post[i], g_hg[i],
                         lb_f_all[i].reshape(HG_HEADS, HG_DK), lb_b_all[i].reshape(HG_HEADS, HG_DK),
                         w_pg[i], w_pp[i], g_ple[i])
    return h
```

```cpp
#include <hip/hip_runtime.h>
#include <cstdio>
#include <cstdint>

typedef unsigned short bf16_t;
constexpr int BATCH = 4, SEQ = 4096, T = BATCH * SEQ, DM = 2048, INW = 9216, PLE = 256;
constexpr int C_Q = 0, C_K = 1024, C_V = 2048, C_AG = 3072, C_HQ = 4096, C_FF = 5120, C_FB = 6144, C_HV = 7168, C_HG = 8192;
constexpr float EPS = 1e-6f;
constexpr size_t MiB = 1u << 20;
constexpr size_t WS_TAB = 0;
constexpr size_t WS_R1 = 2 * MiB;
constexpr size_t WS_Z = WS_R1 + 64 * MiB;
constexpr size_t WS_OF = WS_Z + 288 * MiB;
constexpr size_t WS_OB = WS_OF + 32 * MiB;
constexpr size_t WS_PB = WS_OB + 32 * MiB;
constexpr size_t WS_END = WS_PB + 8 * MiB;

__device__ __forceinline__ float bf2f(bf16_t v) { return __uint_as_float(((unsigned)v) << 16); }
__device__ __forceinline__ bf16_t f2bf(float f) { unsigned u = __float_as_uint(f); return (bf16_t)((u + 0x7fffu + ((u >> 16) & 1u)) >> 16); }
__device__ __forceinline__ float sigmoidf_(float x) { return 1.f / (1.f + __expf(-x)); }
__device__ __forceinline__ float siluf_(float x) { return x / (1.f + __expf(-x)); }
__device__ __forceinline__ float wave_sum(float v) {
#pragma unroll
    for (int o = 1; o < 64; o <<= 1) v += __shfl_xor(v, o);
    return v;
}

__constant__ float ROPE_INV[8] = {1.0f, 0.1939227432012558f, 0.03760603070259094f, 0.007292664609849453f, 0.0014142135623842478f, 0.00027424818836152554f, 5.318296098266728e-05f, 1.0313386155758053e-05f};
__global__ void k_prep(const int* __restrict__ pos, const float* __restrict__ lbf_in, const float* __restrict__ lbb_in, float* tab) {
    const int gid = blockIdx.x * blockDim.x + threadIdx.x, gsz = gridDim.x * blockDim.x;
    for (int i = gid; i < 2048; i += gsz) {
        const float* src = (i < 1024) ? lbf_in : lbb_in; const int k = i & 1023;
        const float a0 = src[k], a1 = src[1024 + k], m = fmaxf(a0, a1), e0 = __expf(a0 - m), e1 = __expf(a1 - m);
        tab[i] = e0 / (e0 + e1);
    }
    float* ct = tab + 16384; float* st = ct + T * 8;
    for (int i = gid; i < T * 8; i += gsz) {
        const int m = i >> 3, j = i & 7;
        const float ang = (float)pos[m] * ROPE_INV[j];
        const double a = (double)ang, k = rint(a * 0.15915494309189535), r = fma(-k, 1.2246467991473532e-16 * 2.0, fma(-k, 6.283185307179586, a));
        const double r2 = r * r; double s = 0.0, c = 0.0;
        double ts = 1.0, tc = 1.0;
#pragma unroll 1
        for (int n = 0; n < 14; ++n) { c += tc; s += ts; tc *= -r2 / (double)((2 * n + 1) * (2 * n + 2)); ts *= -r2 / (double)((2 * n + 2) * (2 * n + 3)); }
        ct[i] = (float)c; st[i] = (float)(s * r);
    }
}
__global__ void k_rmsnorm_u(const float* __restrict__ x, const float* __restrict__ g, bf16_t* __restrict__ u) {
    const int lane = threadIdx.x & 63, gw = (blockIdx.x * blockDim.x + threadIdx.x) >> 6, nw = (gridDim.x * blockDim.x) >> 6;
    for (int m = gw; m < T; m += nw) {
        const float4* xr = (const float4*)(x + (size_t)m * DM); float4 v[8]; float s = 0.f;
#pragma unroll
        for (int j = 0; j < 8; ++j) { v[j] = xr[lane + 64 * j]; s += v[j].x * v[j].x + v[j].y * v[j].y + v[j].z * v[j].z + v[j].w * v[j].w; }
        const float r = rsqrtf(wave_sum(s) * (1.f / DM) + EPS);
#pragma unroll
        for (int j = 0; j < 8; ++j) { const float4 gg = ((const float4*)g)[lane + 64 * j]; bf16_t* o = u + (size_t)m * DM + (lane + 64 * j) * 4;
            o[0] = f2bf(v[j].x * r * gg.x); o[1] = f2bf(v[j].y * r * gg.y); o[2] = f2bf(v[j].z * r * gg.z); o[3] = f2bf(v[j].w * r * gg.w); }
    }
}
__global__ void k_cvt(const float* __restrict__ in, bf16_t* __restrict__ out, size_t n) {
    for (size_t i = (size_t)blockIdx.x * blockDim.x + threadIdx.x; i < n; i += (size_t)gridDim.x * blockDim.x) out[i] = f2bf(in[i]);
}
template <bool OUT_BF16>
__global__ void __launch_bounds__(256) k_gemm_naive(const bf16_t* __restrict__ A, const float* __restrict__ W, void* __restrict__ Cout, int M, int N, int K) {
    __shared__ float As[16][65]; __shared__ float Bs[16][65];
    const int tx = threadIdx.x & 15, ty = threadIdx.x >> 4, nbn = N / 64; const int nblk = (M / 64) * nbn;
    for (int blk = blockIdx.x; blk < nblk; blk += gridDim.x) {
        const int bm = blk / nbn, bn = blk % nbn; float acc[4][4] = {};
        for (int k0 = 0; k0 < K; k0 += 16) {
            __syncthreads();
            for (int i = threadIdx.x; i < 1024; i += 256) { const int r = i >> 4, c = i & 15; As[c][r] = bf2f(A[(size_t)(bm * 64 + r) * K + k0 + c]); }
            for (int i = threadIdx.x; i < 1024; i += 256) { const int r = i >> 6, c = i & 63; Bs[r][c] = bf2f(f2bf(W[(size_t)(k0 + r) * N + bn * 64 + c])); }
            __syncthreads();
#pragma unroll
            for (int kk = 0; kk < 16; ++kk) { float a[4], b[4];
#pragma unroll
                for (int i = 0; i < 4; ++i) { a[i] = As[kk][ty * 4 + i]; b[i] = Bs[kk][tx * 4 + i]; }
#pragma unroll
                for (int i = 0; i < 4; ++i)
#pragma unroll
                    for (int j = 0; j < 4; ++j) acc[i][j] += a[i] * b[j]; }
        }
#pragma unroll
        for (int i = 0; i < 4; ++i)
#pragma unroll
            for (int j = 0; j < 4; ++j) { const size_t o = (size_t)(bm * 64 + ty * 4 + i) * N + bn * 64 + tx * 4 + j;
                if (OUT_BF16) ((bf16_t*)Cout)[o] = f2bf(acc[i][j]); else ((float*)Cout)[o] = acc[i][j]; }
    }
}
__global__ void k_rope(bf16_t* Z, const float* __restrict__ tab) {
    const float* ct = tab + 16384; const float* st = ct + T * 8;
    const size_t n = (size_t)T * 2 * 16 * 8;
    for (size_t i = (size_t)blockIdx.x * blockDim.x + threadIdx.x; i < n; i += (size_t)gridDim.x * blockDim.x) {
        const int j = i & 7, h = (i >> 3) & 15, qk = (i >> 7) & 1; const int m = (int)(i >> 8);
        bf16_t* p = Z + (size_t)m * INW + (qk ? C_K : C_Q) + h * 64 + j;
        const float x1 = bf2f(p[0]), x2 = bf2f(p[8]), c = ct[m * 8 + j], s = st[m * 8 + j];
        p[0] = f2bf(x1 * c - x2 * s); p[8] = f2bf(x2 * c + x1 * s);
    }
}
__global__ void __launch_bounds__(256) k_attn_naive(const bf16_t* __restrict__ Z, bf16_t* __restrict__ Y) {
    const int n = T * 16;
    for (int i = blockIdx.x * blockDim.x + threadIdx.x; i < n; i += gridDim.x * blockDim.x) {
        const int h = i & 15, m = i >> 4, b = m / SEQ, s = m % SEQ;
        float q[64], o[64]; const bf16_t* qp = Z + (size_t)m * INW + C_Q + h * 64;
#pragma unroll
        for (int d = 0; d < 64; ++d) { q[d] = bf2f(qp[d]) * 0.125f; o[d] = 0.f; }
        float mx = -1e30f, l = 0.f;
        for (int g = 0; g < 3; ++g) { const int dil = (g == 0) ? 1 : (g == 1 ? 4 : 16);
            for (int mm = -64; mm <= 64; ++mm) { const int j = s + dil * mm; if (j < 0 || j >= SEQ) continue;
                const bf16_t* kp = Z + (size_t)(b * SEQ + j) * INW + C_K + h * 64; const bf16_t* vp = kp + (C_V - C_K);
                float sc = 0.f;
#pragma unroll
                for (int d = 0; d < 64; ++d) sc += q[d] * bf2f(kp[d]);
                const float mn = fmaxf(mx, sc), f = __expf(mx - mn), p = __expf(sc - mn);
                l = l * f + p; mx = mn;
#pragma unroll
                for (int d = 0; d < 64; ++d) o[d] = o[d] * f + p * bf2f(vp[d]);
            } }
        const float il = 1.f / l; const bf16_t* gp = Z + (size_t)m * INW + C_AG + h * 64; bf16_t* yp = Y + (size_t)m * DM + h * 64;
#pragma unroll
        for (int d = 0; d < 64; ++d) yp[d] = f2bf(o[d] * il * siluf_(bf2f(gp[d])));
    }
}
__global__ void __launch_bounds__(128) k_hgrn_naive(const bf16_t* __restrict__ Z, const float* __restrict__ tab, bf16_t* __restrict__ OF, bf16_t* __restrict__ OB) {
    __shared__ float qs[16][128], fs[16][128], vs[16][128];
    const int dir = blockIdx.x & 1, h = (blockIdx.x >> 1) & 7, b = blockIdx.x >> 4, v = threadIdx.x;
    const float lb = tab[dir * 1024 + h * 128 + v];
    float S[128];
#pragma unroll
    for (int k = 0; k < 128; ++k) S[k] = 0.f;
    bf16_t* O = dir ? OB : OF;
    for (int c0 = 0; c0 < SEQ; c0 += 16) {
        __syncthreads();
        for (int tt = 0; tt < 16; ++tt) { const int s = dir ? (SEQ - 1 - (c0 + tt)) : (c0 + tt); const bf16_t* zr = Z + (size_t)(b * SEQ + s) * INW;
            qs[tt][v] = siluf_(bf2f(zr[C_HQ + h * 128 + v]));
            fs[tt][v] = lb + (1.f - lb) * sigmoidf_(bf2f(zr[(dir ? C_FB : C_FF) + h * 128 + v]));
            vs[tt][v] = bf2f(zr[C_HV + h * 128 + v]); }
        __syncthreads();
        for (int tt = 0; tt < 16; ++tt) { const float vv = vs[tt][v]; float o = 0.f;
#pragma unroll
            for (int k = 0; k < 128; ++k) { const float f = fs[tt][k]; S[k] = f * S[k] + (1.f - f) * vv; o += S[k] * qs[tt][k]; }
            const int s = dir ? (SEQ - 1 - (c0 + tt)) : (c0 + tt);
            O[(size_t)(b * SEQ + s) * 1024 + h * 128 + v] = f2bf(o); }
    }
}
__global__ void k_combine(const bf16_t* __restrict__ Z, const bf16_t* __restrict__ OF, const bf16_t* __restrict__ OB, const float* __restrict__ ghg, bf16_t* __restrict__ Y) {
    const int lane = threadIdx.x & 63, gw = (blockIdx.x * blockDim.x + threadIdx.x) >> 6, nw = (gridDim.x * blockDim.x) >> 6;
    for (int i = gw; i < T * 8; i += nw) { const int m = i >> 3, h = i & 7; const size_t o = (size_t)m * 1024 + h * 128;
        const float a0 = bf2f(OF[o + lane]) + bf2f(OB[o + lane]), a1 = bf2f(OF[o + 64 + lane]) + bf2f(OB[o + 64 + lane]);
        const float r = rsqrtf(wave_sum(a0 * a0 + a1 * a1) * (1.f / 128.f) + EPS);
        const bf16_t* gp = Z + (size_t)m * INW + C_HG + h * 128;
        Y[(size_t)m * DM + 1024 + h * 128 + lane] = f2bf(a0 * r * ghg[lane] * siluf_(bf2f(gp[lane])));
        Y[(size_t)m * DM + 1024 + h * 128 + 64 + lane] = f2bf(a1 * r * ghg[64 + lane] * siluf_(bf2f(gp[64 + lane]))); }
}
__global__ void k_h1(const float* __restrict__ x, const float* __restrict__ y2, const float* __restrict__ g, float* __restrict__ out, bf16_t* __restrict__ h1b) {
    const int lane = threadIdx.x & 63, gw = (blockIdx.x * blockDim.x + threadIdx.x) >> 6, nw = (gridDim.x * blockDim.x) >> 6;
    for (int m = gw; m < T; m += nw) {
        const float4* yr = (const float4*)(y2 + (size_t)m * DM); float4 v[8]; float s = 0.f;
#pragma unroll
        for (int j = 0; j < 8; ++j) { v[j] = yr[lane + 64 * j]; s += v[j].x * v[j].x + v[j].y * v[j].y + v[j].z * v[j].z + v[j].w * v[j].w; }
        const float r = rsqrtf(wave_sum(s) * (1.f / DM) + EPS);
#pragma unroll
        for (int j = 0; j < 8; ++j) { const int c4 = lane + 64 * j; const float4 gg = ((const float4*)g)[c4], xx = ((const float4*)(x + (size_t)m * DM))[c4];
            float4 hh; hh.x = xx.x + v[j].x * r * gg.x; hh.y = xx.y + v[j].y * r * gg.y; hh.z = xx.z + v[j].z * r * gg.z; hh.w = xx.w + v[j].w * r * gg.w;
            ((float4*)(out + (size_t)m * DM))[c4] = hh; bf16_t* o = h1b + (size_t)m * DM + c4 * 4; o[0] = f2bf(hh.x); o[1] = f2bf(hh.y); o[2] = f2bf(hh.z); o[3] = f2bf(hh.w); }
    }
}
__global__ void k_final(const float* __restrict__ G, const float* __restrict__ E, const float* __restrict__ g, float* __restrict__ out) {
    const int lane = threadIdx.x & 63, gw = (blockIdx.x * blockDim.x + threadIdx.x) >> 6, nw = (gridDim.x * blockDim.x) >> 6;
    for (int m = gw; m < T; m += nw) {
        float4 v[8]; float s = 0.f;
#pragma unroll
        for (int j = 0; j < 8; ++j) { const float4 a = ((const float4*)(G + (size_t)m * DM))[lane + 64 * j], e = ((const float4*)(E + (size_t)m * DM))[lane + 64 * j];
            v[j].x = sigmoidf_(a.x) * e.x; v[j].y = sigmoidf_(a.y) * e.y; v[j].z = sigmoidf_(a.z) * e.z; v[j].w = sigmoidf_(a.w) * e.w;
            s += v[j].x * v[j].x + v[j].y * v[j].y + v[j].z * v[j].z + v[j].w * v[j].w; }
        const float r = rsqrtf(wave_sum(s) * (1.f / DM) + EPS);
#pragma unroll
        for (int j = 0; j < 8; ++j) { const int c4 = lane + 64 * j; const float4 gg = ((const float4*)g)[c4]; float4 hh = ((float4*)(out + (size_t)m * DM))[c4];
            hh.x += v[j].x * r * gg.x; hh.y += v[j].y * r * gg.y; hh.z += v[j].z * r * gg.z; hh.w += v[j].w * r * gg.w; ((float4*)(out + (size_t)m * DM))[c4] = hh; }
    }
}

extern "C" void kernel_launch(void* const* d_in, const int* in_sizes, int n_in, void* d_out, int out_size, void* d_ws, size_t ws_size, hipStream_t stream) {
    if (n_in != 13 || in_sizes[0] != T * DM || out_size != T * DM || ws_size < WS_END) { fprintf(stderr, "kernel_launch: unexpected shapes n_in %d in0 %d out %d ws %zu (need %zu)\n", n_in, n_in > 0 ? in_sizes[0] : -1, out_size, ws_size, (size_t)WS_END); return; }
    const float* x = (const float*)d_in[0]; const float* p = (const float*)d_in[1]; const int* pos = (const int*)d_in[2];
    const float* w_in = (const float*)d_in[3]; const float* w_out = (const float*)d_in[4]; const float* g_pre = (const float*)d_in[5]; const float* g_post = (const float*)d_in[6];
    const float* g_hg = (const float*)d_in[7]; const float* lb_fwd = (const float*)d_in[8]; const float* lb_bwd = (const float*)d_in[9];
    const float* w_pg = (const float*)d_in[10]; const float* w_pp = (const float*)d_in[11]; const float* g_ple = (const float*)d_in[12];
    float* out = (float*)d_out; unsigned char* ws = (unsigned char*)d_ws;
    float* tab = (float*)(ws + WS_TAB); bf16_t* U = (bf16_t*)(ws + WS_R1); bf16_t* Y = U; bf16_t* H1b = U; bf16_t* Z = (bf16_t*)(ws + WS_Z);
    float* Y2 = (float*)(ws + WS_Z); float* G = Y2; float* E = (float*)(ws + WS_Z + 128 * MiB);
    bf16_t* OF = (bf16_t*)(ws + WS_OF); bf16_t* OB = (bf16_t*)(ws + WS_OB); bf16_t* PB = (bf16_t*)(ws + WS_PB);
    k_prep<<<256, 256, 0, stream>>>(pos, lb_fwd, lb_bwd, tab);
    k_rmsnorm_u<<<1024, 256, 0, stream>>>(x, g_pre, U);
    k_cvt<<<1024, 256, 0, stream>>>(p, PB, (size_t)T * PLE);
    k_gemm_naive<true><<<2048, 256, 0, stream>>>(U, w_in, Z, T, INW, DM);
    k_rope<<<2048, 256, 0, stream>>>(Z, tab);
    k_attn_naive<<<1024, 256, 0, stream>>>(Z, Y);
    k_hgrn_naive<<<64, 128, 0, stream>>>(Z, tab, OF, OB);
    k_combine<<<2048, 256, 0, stream>>>(Z, OF, OB, g_hg, Y);
    k_gemm_naive<false><<<2048, 256, 0, stream>>>(Y, w_out, Y2, T, DM, DM);
    k_h1<<<1024, 256, 0, stream>>>(x, Y2, g_post, out, H1b);
    k_gemm_naive<false><<<2048, 256, 0, stream>>>(H1b, w_pg, G, T, DM, DM);
    k_gemm_naive<false><<<2048, 256, 0, stream>>>(PB, w_pp, E, T, DM, PLE);
    k_final<<<1024, 256, 0, stream>>>(G, E, g_ple, out);
}
```

```cpp
#include <hip/hip_runtime.h>
#include <hip/hip_cooperative_groups.h>
#include <cstdio>
#include <cstdint>
namespace cg = cooperative_groups;
namespace pg8 {
#define PG8_LAS __attribute__((address_space(3)))
typedef unsigned short bf16_t;
typedef short bf16x8 __attribute__((ext_vector_type(8)));
typedef float f32x4 __attribute__((ext_vector_type(4)));
typedef unsigned u32x4 __attribute__((ext_vector_type(4)));
constexpr int BM = 256, BK = 64, HALF = 128, HTB = HALF * BK * 2  , STAGE_BYTES = 8 * HTB, NXCD = 8, WGM = 8;

__host__ __device__ __forceinline__ int lds_byte(int r, int c) { const int st = (r >> 4) * 2 + (c >> 5), rr = r & 15, cc = c & 31, ob = rr * 64 + cc * 2; return st * 1024 + (ob ^ (((ob >> 9) & 1) << 5)); }
__host__ __device__ __forceinline__ void stage_rc(int b, int& R, int& C) { const int st = b / 1024, sb = b % 1024, swz = sb ^ (((sb >> 9) & 1) << 5); R = (st >> 1) * 16 + swz / 64; C = (st & 1) * 32 + (swz % 64) / 2; }
__host__ __device__ __forceinline__ int perm32(int rho) { const int n = rho >> 4, i = rho & 15; return 8 * (i >> 2) + 4 * n + (i & 3); }

struct Unit { int pm, pn; };
struct Gemm { const bf16_t* A; const bf16_t* Bt; int M, N, K; };

struct StaticOrder {
    int nM, nN, nwg, G, c;
    __host__ __device__ void init(int M, int N, int G_, int c_) { nM = M / BM; nN = N / BM; nwg = nM * nN; G = G_; c = c_; }
    __host__ __device__ bool next(int i, Unit& u) const {
        const long L = (long)i * G + c; if (L >= nwg) return false;
        int wgid = (int)L; { const int q = nwg / NXCD, r = nwg % NXCD, xcd = wgid % NXCD, off = wgid / NXCD; wgid = (xcd < r ? xcd * (q + 1) : r * (q + 1) + (xcd - r) * q) + off; }
        const int nig = WGM * nN, gid = wgid / nig, fm = gid * WGM, gsz = (nM - fm) < WGM ? (nM - fm) : WGM;
        u.pm = fm + ((wgid % nig) % gsz); u.pn = (wgid % nig) / gsz; return true;
    }
    __device__ __forceinline__ void a_ready(const Unit&) const {}
    __device__ __forceinline__ void done(const Unit&) const {}
};

__device__ __forceinline__ unsigned cvt_pk_bf16(float lo, float hi) { unsigned r; asm volatile("v_cvt_pk_bf16_f32 %0, %1, %2" : "=v"(r) : "v"(lo), "v"(hi)); return r; }
typedef float f32x2 __attribute__((ext_vector_type(2)));
__device__ __forceinline__ f32x2 gelu_pk(f32x2 v) {
    const f32x2 av = __builtin_elementwise_abs(v), d = av * 0.2316418882f + 1.0f;
    f32x2 t; t.x = __builtin_amdgcn_rcpf(d.x); t.y = __builtin_amdgcn_rcpf(d.y);
    f32x2 q = t * 0.5307027145f + (-0.7265760135f); q = q * t + 0.7107068705f; q = q * t + (-0.142248368f); q = q * t + 0.127414796f; q = q * t;
    const f32x2 s = (v * v) * (-0.72134752044f);
    f32x2 e; e.x = __builtin_amdgcn_exp2f(s.x); e.y = __builtin_amdgcn_exp2f(s.y);
    const f32x2 m = v * (q * e), r = v - m;
    f32x2 o; o.x = v.x < 0.f ? m.x : r.x; o.y = v.y < 0.f ? m.y : r.y; return o;
}

template <int ACT  > struct EpiBf16 {
    static constexpr bool PERM = true, AFTER_DRAIN = false; static_assert(ACT == 0 || ACT == 1, "EpiBf16: ACT is 0 (none) or 1 (gelu_pk)");
    bf16_t* O; int ldc; const float* bias; int split_cols; size_t split_stride; float scale0;
    __device__ __forceinline__ void operator()(const f32x4 (&acc)[2][2][4][2], const Unit& u, int wr, int wc, int fr, int fq) const {
        const int row0 = u.pm * BM + wr * 64 + fr; int colt = u.pn * BM; bf16_t* base = O;
        float sc = 1.f; if (split_cols) { const int t = colt / split_cols; base += (size_t)t * split_stride; colt -= t * split_cols; if (t == 0) sc = scale0; }
        const int col0 = colt + wc * 32 + 8 * fq, bcol0 = u.pn * BM + wc * 32 + 8 * fq;
        f32x4 bv[2][2];
#pragma unroll
        for (int bj = 0; bj < 2; ++bj)
#pragma unroll
            for (int n = 0; n < 2; ++n) bv[bj][n] = bias ? *(const f32x4*)(bias + bcol0 + bj * HALF + 4 * n) : (f32x4){0.f, 0.f, 0.f, 0.f};
#pragma unroll
        for (int ai = 0; ai < 2; ++ai)
#pragma unroll
            for (int m = 0; m < 4; ++m) { bf16_t* rowp = base + (size_t)(row0 + ai * HALF + m * 16) * ldc + col0;
#pragma unroll
                for (int bj = 0; bj < 2; ++bj) { f32x4 v0 = acc[ai][bj][m][0] + bv[bj][0], v1 = acc[ai][bj][m][1] + bv[bj][1];
                    if (ACT == 1) { f32x2 a = gelu_pk((f32x2){v0[0], v0[1]}), b = gelu_pk((f32x2){v0[2], v0[3]}), c = gelu_pk((f32x2){v1[0], v1[1]}), d = gelu_pk((f32x2){v1[2], v1[3]});
                        v0 = (f32x4){a.x, a.y, b.x, b.y}; v1 = (f32x4){c.x, c.y, d.x, d.y}; }
                    v0 = v0 * sc; v1 = v1 * sc; u32x4 w; w.x = cvt_pk_bf16(v0[0], v0[1]); w.y = cvt_pk_bf16(v0[2], v0[3]); w.z = cvt_pk_bf16(v1[0], v1[1]); w.w = cvt_pk_bf16(v1[2], v1[3]);
                    *(u32x4*)(rowp + bj * HALF) = w; } }
    }
};
struct EpiF32 {
    static constexpr bool PERM = false, AFTER_DRAIN = false;
    float* O; int ldc;
    __device__ __forceinline__ void operator()(const f32x4 (&acc)[2][2][4][2], const Unit& u, int wr, int wc, int fr, int fq) const {
        const int col0 = u.pn * BM + wc * 32 + 4 * fq;
#pragma unroll
        for (int ai = 0; ai < 2; ++ai)
#pragma unroll
            for (int m = 0; m < 4; ++m) { float* rowp = O + (size_t)(u.pm * BM + ai * HALF + wr * 64 + m * 16 + fr) * ldc + col0;
#pragma unroll
                for (int bj = 0; bj < 2; ++bj)
#pragma unroll
                    for (int n = 0; n < 2; ++n) *(f32x4*)(rowp + bj * HALF + n * 16) = acc[ai][bj][m][n]; }
    }
};

template <class Epi, class Sched, bool ALIGN_EPI = false, bool SP2 = false>
__device__ __forceinline__ void gemm_phase(PG8_LAS unsigned char* lds, const Gemm g, const Sched& S, const Epi& E) {
    const int tid = threadIdx.x, wid = __builtin_amdgcn_readfirstlane(tid >> 6), lane = tid & 63, wr = wid >> 2, wc = wid & 3, fr = lane & 15, fq = lane >> 4;
    const int K = g.K, nt = K / BK;
    unsigned voffA[2], voffB[2];
#pragma unroll
    for (int i = 0; i < 2; ++i) { int R, C; stage_rc(tid * 16 + i * 8192, R, C); const int Rb = Epi::PERM ? ((R & ~31) + perm32(R & 31)) : R;
        voffA[i] = (unsigned)(R * K + C) * 2u; voffB[i] = (unsigned)(Rb * K + C) * 2u; }
    const size_t kstep = (size_t)(BK * 2);
    const size_t hstep = (size_t)HALF * K * 2;
    const size_t tstep = 2 * hstep;
    const unsigned ldsw = (unsigned)wid * 1024u;
    const int aoff = lds_byte(wr * 64 + fr, fq * 8), boff = lds_byte(wc * 32 + fr, fq * 8);
#define PG8_SA(b, h) (((b) * 2 + (h)) * HTB)
#define PG8_SB(b, h) ((4 + (b) * 2 + (h)) * HTB)
#define PG8_STAGE(bufoff, gbase, voff) do { _Pragma("unroll") for (int _i = 0; _i < 2; ++_i) \
        __builtin_amdgcn_global_load_lds((const unsigned*)((const char*)(gbase) + (voff)[_i]), (PG8_LAS unsigned*)(lds + (bufoff) + ldsw + _i * 8192), 16, 0, 0); } while (0)
#define PG8_LDA(dst, b, h) do { _Pragma("unroll") for (int m = 0; m < 4; ++m) _Pragma("unroll") for (int k = 0; k < 2; ++k) dst[m][k] = *(const PG8_LAS bf16x8*)(lds + PG8_SA(b, h) + aoff + m * 2048 + k * 1024); } while (0)
#define PG8_LDB(dst, b, h) do { _Pragma("unroll") for (int n = 0; n < 2; ++n) _Pragma("unroll") for (int k = 0; k < 2; ++k) dst[n][k] = *(const PG8_LAS bf16x8*)(lds + PG8_SB(b, h) + boff + n * 2048 + k * 1024); } while (0)
#define PG8_MMA(ai, bj, At, Bt) do { __builtin_amdgcn_s_setprio(1); _Pragma("unroll") for (int m = 0; m < 4; ++m) _Pragma("unroll") for (int n = 0; n < 2; ++n) _Pragma("unroll") for (int k = 0; k < 2; ++k) \
        acc[ai][bj][m][n] = __builtin_amdgcn_mfma_f32_16x16x32_bf16(Bt[n][k], At[m][k], acc[ai][bj][m][n], 0, 0, 0); __builtin_amdgcn_s_setprio(0); } while (0)
#define PG8_WAIT_V(n) asm volatile("s_waitcnt vmcnt(" #n ")" ::: "memory")
#define PG8_WAIT_L(n) asm volatile("s_waitcnt lgkmcnt(" #n ")" ::: "memory")
#define PG8_BAR __builtin_amdgcn_s_barrier()
#define PG8_SCHED __builtin_amdgcn_sched_barrier(0)
    Unit cur, nxt; int ui = 0;
    if (!S.next(0, cur)) return;
    f32x4 acc[2][2][4][2];
#pragma unroll
    for (int a = 0; a < 2; ++a)
#pragma unroll
        for (int b = 0; b < 2; ++b)
#pragma unroll
            for (int m = 0; m < 4; ++m)
#pragma unroll
                for (int n = 0; n < 2; ++n) acc[a][b][m][n] = (f32x4){0.f, 0.f, 0.f, 0.f};
    bf16x8 At[4][2], B0[2][2], B1[2][2];
    const char* cA = (const char*)g.A + (size_t)cur.pm * tstep; const char* cB = (const char*)g.Bt + (size_t)cur.pn * tstep;
    S.a_ready(cur);
    if constexpr (SP2) {
        PG8_STAGE(PG8_SB(0, 0), cB, voffB); PG8_STAGE(PG8_SB(0, 1), cB + hstep, voffB); PG8_STAGE(PG8_SA(0, 0), cA, voffA); PG8_STAGE(PG8_SA(0, 1), cA + hstep, voffA);
        if (wr == 1) PG8_BAR;
        PG8_WAIT_V(2); PG8_BAR;
        PG8_STAGE(PG8_SB(1, 0), cB + kstep, voffB); PG8_STAGE(PG8_SA(1, 0), cA + kstep, voffA); PG8_STAGE(PG8_SB(1, 1), cB + hstep + kstep, voffB);
        PG8_WAIT_V(6); PG8_BAR;
    } else {
        PG8_STAGE(PG8_SB(0, 0), cB, voffB); PG8_STAGE(PG8_SA(0, 0), cA, voffA); PG8_STAGE(PG8_SB(0, 1), cB + hstep, voffB); PG8_STAGE(PG8_SA(0, 1), cA + hstep, voffA);
        if (wr == 1) PG8_BAR;
        PG8_WAIT_V(4); PG8_BAR;
        PG8_STAGE(PG8_SB(1, 0), cB + kstep, voffB); PG8_STAGE(PG8_SA(1, 0), cA + kstep, voffA); PG8_STAGE(PG8_SB(1, 1), cB + hstep + kstep, voffB);
        PG8_WAIT_V(6); PG8_BAR;
    }
    for (;;) {
        const bool has_next = S.next(ui + 1, nxt);
        const char* nA = has_next ? (const char*)g.A + (size_t)nxt.pm * tstep : cA; const char* nB = has_next ? (const char*)g.Bt + (size_t)nxt.pn * tstep : cB;
        for (int t = 0; t < nt; t += 2) {
            const bool last = (t == nt - 2);
            const char* a1 = cA + (size_t)(t + 1) * kstep;
            const char* a2 = last ? nA : cA + (size_t)(t + 2) * kstep; const char* b2 = last ? nB : cB + (size_t)(t + 2) * kstep;
            const char* a3 = a2 + kstep; const char* b3 = b2 + kstep;
            if (last && has_next) S.a_ready(nxt);
            if constexpr (SP2) {
            PG8_LDB(B0, 0, 0); PG8_LDB(B1, 0, 1); PG8_SCHED; PG8_LDA(At, 0, 0); PG8_STAGE(PG8_SA(1, 1), a1 + hstep, voffA);
            PG8_WAIT_V(8); PG8_WAIT_L(0); PG8_BAR; PG8_MMA(0, 0, At, B0); PG8_MMA(0, 1, At, B1); PG8_BAR; PG8_SCHED;
            PG8_LDA(At, 0, 1); PG8_STAGE(PG8_SB(0, 0), b2, voffB); PG8_STAGE(PG8_SB(0, 1), b2 + hstep, voffB); PG8_STAGE(PG8_SA(0, 0), a2, voffA);
            PG8_WAIT_V(8); PG8_WAIT_L(0); PG8_BAR; PG8_MMA(1, 0, At, B0); PG8_MMA(1, 1, At, B1); PG8_BAR; PG8_SCHED;
            PG8_LDB(B0, 1, 0); PG8_LDB(B1, 1, 1); PG8_SCHED; PG8_LDA(At, 1, 0); PG8_STAGE(PG8_SA(0, 1), a2 + hstep, voffA);
            PG8_WAIT_V(8); PG8_WAIT_L(0); PG8_BAR; PG8_MMA(0, 0, At, B0); PG8_MMA(0, 1, At, B1); PG8_BAR; PG8_SCHED;
            PG8_LDA(At, 1, 1); PG8_STAGE(PG8_SB(1, 0), b3, voffB); PG8_STAGE(PG8_SB(1, 1), b3 + hstep, voffB); PG8_STAGE(PG8_SA(1, 0), a3, voffA);
            PG8_WAIT_V(8); PG8_WAIT_L(0); PG8_BAR; PG8_MMA(1, 0, At, B0); PG8_MMA(1, 1, At, B1); PG8_BAR; PG8_SCHED;
            } else {
            PG8_LDB(B0, 0, 0); PG8_SCHED; PG8_LDA(At, 0, 0); PG8_STAGE(PG8_SA(1, 1), a1 + hstep, voffA);
            PG8_WAIT_L(8); PG8_BAR; PG8_WAIT_L(0); PG8_MMA(0, 0, At, B0); PG8_BAR; PG8_SCHED;
            PG8_LDB(B1, 0, 1); PG8_STAGE(PG8_SB(0, 0), b2, voffB);
            PG8_BAR; PG8_WAIT_L(0); PG8_MMA(0, 1, At, B1); PG8_BAR;
            PG8_LDA(At, 0, 1); PG8_STAGE(PG8_SA(0, 0), a2, voffA);
            PG8_BAR; PG8_WAIT_L(0); PG8_MMA(1, 0, At, B0); PG8_BAR; PG8_SCHED;
            PG8_STAGE(PG8_SB(0, 1), b2 + hstep, voffB);
            PG8_WAIT_V(6); PG8_BAR; PG8_MMA(1, 1, At, B1); PG8_BAR;
            PG8_LDB(B0, 1, 0); PG8_SCHED; PG8_LDA(At, 1, 0); PG8_STAGE(PG8_SA(0, 1), a2 + hstep, voffA);
            PG8_WAIT_L(8); PG8_BAR; PG8_WAIT_L(0); PG8_MMA(0, 0, At, B0); PG8_BAR; PG8_SCHED;
            PG8_LDB(B1, 1, 1); PG8_STAGE(PG8_SB(1, 0), b3, voffB);
            PG8_BAR; PG8_WAIT_L(0); PG8_MMA(0, 1, At, B1); PG8_BAR;
            PG8_LDA(At, 1, 1); PG8_STAGE(PG8_SA(1, 0), a3, voffA);
            PG8_BAR; PG8_WAIT_L(0); PG8_MMA(1, 0, At, B0); PG8_BAR; PG8_SCHED;
            PG8_STAGE(PG8_SB(1, 1), b3 + hstep, voffB);
            PG8_WAIT_V(6); PG8_BAR; PG8_MMA(1, 1, At, B1); PG8_BAR;
            }
        }
        if constexpr (ALIGN_EPI) { if (wr == 0) PG8_BAR; }
        if constexpr (!Epi::AFTER_DRAIN) { E(acc, cur, wr, wc, fr, fq); S.done(cur); }
        if (!has_next) break;
#pragma unroll
        for (int a = 0; a < 2; ++a)
#pragma unroll
            for (int b = 0; b < 2; ++b)
#pragma unroll
                for (int m = 0; m < 4; ++m)
#pragma unroll
                    for (int n = 0; n < 2; ++n) acc[a][b][m][n] = (f32x4){0.f, 0.f, 0.f, 0.f};
        cur = nxt; cA = nA; cB = nB; ++ui;
        if constexpr (ALIGN_EPI) { if (wr == 1) PG8_BAR; }
    }
    PG8_WAIT_V(0);
    if constexpr (!ALIGN_EPI) { if (wr == 0) PG8_BAR; }
    PG8_BAR;
    if constexpr (Epi::AFTER_DRAIN) { E.fused(acc, cur, wr, wc, fr, fq, lds, wid, lane); S.done(cur); }
#undef PG8_SA
#undef PG8_SB
#undef PG8_STAGE
#undef PG8_LDA
#undef PG8_LDB
#undef PG8_MMA
#undef PG8_WAIT_V
#undef PG8_WAIT_L
#undef PG8_BAR
#undef PG8_SCHED
}
}

#ifndef PG8_SP2
#define PG8_SP2 true
#endif
#ifndef PG8_ALIGN
#define PG8_ALIGN true
#endif
typedef unsigned short bf16_t;
#define GAS __attribute__((address_space(1)))
#define LAS __attribute__((address_space(3)))
typedef unsigned v4u __attribute__((ext_vector_type(4)));
constexpr int NWAVES = 8, NTHR = 512;
constexpr int BATCH = 4, SEQ = 4096, T = BATCH * SEQ, DM = 2048, INW = 9216, PLE = 256;
constexpr int C_Q = 0, C_K = 1024, C_V = 2048, C_AG = 3072, C_HQ = 4096, C_FF = 5120, C_FB = 6144, C_HV = 7168, C_HG = 8192;
constexpr float EPS = 1e-6f;
constexpr size_t MiB = 1u << 20;
constexpr size_t WS_TAB = 0;
constexpr size_t WS_WIN = 2 * MiB;
constexpr size_t WS_WOUT = WS_WIN + 36 * MiB;
constexpr size_t WS_WPG = WS_WOUT + 8 * MiB;
constexpr size_t WS_WPP = WS_WPG + 8 * MiB;
constexpr size_t WS_R1 = WS_WPP + 1 * MiB;
constexpr size_t WS_Z = WS_R1 + 64 * MiB;
constexpr size_t WS_OF = WS_Z + 288 * MiB;
constexpr size_t WS_OB = WS_OF + 32 * MiB;
constexpr size_t WS_PB = WS_OB + 32 * MiB;
constexpr size_t WS_END = WS_PB + 8 * MiB;
constexpr int LDS_BYTES = 147456;

__device__ __forceinline__ float bf2f(bf16_t v) { return __uint_as_float(((unsigned)v) << 16); }
__device__ __forceinline__ unsigned f2bf(float f) { unsigned u = __float_as_uint(f); return (u + 0x7fffu + ((u >> 16) & 1u)) >> 16; }
__device__ __forceinline__ unsigned pk2(float lo, float hi) { return f2bf(lo) | (f2bf(hi) << 16); }
__device__ __forceinline__ float sigmoidf_(float x) { return 1.f / (1.f + __expf(-x)); }
__device__ __forceinline__ float siluf_(float x) { return x / (1.f + __expf(-x)); }
__device__ __forceinline__ float wave_sum(float v) {
#pragma unroll
    for (int o = 1; o < 64; o <<= 1) v += __shfl_xor(v, o);
    return v;
}
#define LDS_WAIT() asm volatile("s_waitcnt lgkmcnt(0)" ::: "memory")

struct Args {
    const float* x; const float* p; const int* pos; const float* w_in; const float* w_out; const float* g_pre; const float* g_post; const float* g_hg;
    const float* lb_fwd; const float* lb_bwd; const float* w_pg; const float* w_pp; const float* g_ple; float* out; unsigned char* ws; int ph_lo, ph_hi;
};

__constant__ float ROPE_INV[8] = {1.0f, 0.1939227432012558f, 0.03760603070259094f, 0.007292664609849453f, 0.0014142135623842478f, 0.00027424818836152554f, 5.318296098266728e-05f, 1.0313386155758053e-05f};
__device__ __forceinline__ void p0_transpose_item(const float* W, int K, int N, bf16_t* WT, LAS float* scr, int item, int lane) {
    const int nblk = N / 32, kb = item / nblk, nb = item % nblk, k0 = 64 * kb, n0 = 32 * nb;
#pragma unroll 8
    for (int i = 0; i < 32; ++i) { const int kk = 2 * i + (lane >> 5); scr[kk * 33 + (lane & 31)] = W[(size_t)(k0 + kk) * N + n0 + (lane & 31)]; }
    LDS_WAIT(); asm volatile("" ::: "memory");
    const int c = lane & 7;
#pragma unroll
    for (int j = 0; j < 4; ++j) { const int n = (lane >> 3) + 8 * j; const LAS float* s = scr + (8 * c) * 33 + n;
        v4u o; o.x = pk2(s[0 * 33], s[1 * 33]); o.y = pk2(s[2 * 33], s[3 * 33]); o.z = pk2(s[4 * 33], s[5 * 33]); o.w = pk2(s[6 * 33], s[7 * 33]);
        *(GAS v4u*)(WT + (size_t)(n0 + n) * K + k0 + 8 * c) = o; }
    LDS_WAIT(); asm volatile("" ::: "memory");
}
__device__ __forceinline__ void p0_prologue(const Args& a, LAS unsigned char* lds) {
    const int tid = threadIdx.x, lane = tid & 63, wave = tid >> 6;
    const int gw = blockIdx.x * NWAVES + wave, NGW = gridDim.x * NWAVES, gid = blockIdx.x * NTHR + tid, gsz = gridDim.x * NTHR;
    unsigned char* ws = a.ws; float* tab = (float*)(ws + WS_TAB);
    for (int i = gid; i < 2048; i += gsz) { const float* src = (i < 1024) ? a.lb_fwd : a.lb_bwd; const int k = i & 1023;
        const float a0 = src[k], a1 = src[1024 + k], m = fmaxf(a0, a1), e0 = __expf(a0 - m), e1 = __expf(a1 - m); tab[i] = e0 / (e0 + e1); }
    { float* ct = tab + 16384; float* st = ct + T * 8;
      for (int i = gid; i < T * 8; i += gsz) { const int m = i >> 3, j = i & 7; const float ang = (float)a.pos[m] * ROPE_INV[j];
        const double av = (double)ang, k = rint(av * 0.15915494309189535), r = fma(-k, 2.4492935982947064e-16, fma(-k, 6.283185307179586, av));
        const double r2 = r * r; double s = 0.0, c = 0.0, ts = 1.0, tc = 1.0;
#pragma unroll 1
        for (int n = 0; n < 14; ++n) { c += tc; s += ts; tc *= -r2 / (double)((2 * n + 1) * (2 * n + 2)); ts *= -r2 / (double)((2 * n + 2) * (2 * n + 3)); }
        ct[i] = (float)c; st[i] = (float)(s * r); } }
    LAS float* scr = (LAS float*)(lds + wave * 16384);
    constexpr int I_IN = (DM / 64) * (INW / 32), I_SQ = (DM / 64) * (DM / 32), I_PP = (PLE / 64) * (DM / 32), NITEMS = I_IN + 2 * I_SQ + I_PP;
    for (int it = gw; it < NITEMS; it += NGW) { int r = it;
        if (r < I_IN) { p0_transpose_item(a.w_in, DM, INW, (bf16_t*)(ws + WS_WIN), scr, r, lane); continue; } r -= I_IN;
        if (r < I_SQ) { p0_transpose_item(a.w_out, DM, DM, (bf16_t*)(ws + WS_WOUT), scr, r, lane); continue; } r -= I_SQ;
        if (r < I_SQ) { p0_transpose_item(a.w_pg, DM, DM, (bf16_t*)(ws + WS_WPG), scr, r, lane); continue; } r -= I_SQ;
        p0_transpose_item(a.w_pp, PLE, DM, (bf16_t*)(ws + WS_WPP), scr, r, lane); }
    bf16_t* U = (bf16_t*)(ws + WS_R1);
    for (int m = gw; m < T; m += NGW) {
        const float4* xr = (const float4*)(a.x + (size_t)m * DM); float4 v[8]; float s = 0.f;
#pragma unroll
        for (int j = 0; j < 8; ++j) { v[j] = xr[lane + 64 * j]; s += v[j].x * v[j].x + v[j].y * v[j].y + v[j].z * v[j].z + v[j].w * v[j].w; }
        const float r = rsqrtf(wave_sum(s) * (1.f / DM) + EPS);
#pragma unroll
        for (int j = 0; j < 8; ++j) { const float4 gg = ((const float4*)a.g_pre)[lane + 64 * j];
            uint2 o; o.x = pk2(v[j].x * r * gg.x, v[j].y * r * gg.y); o.y = pk2(v[j].z * r * gg.z, v[j].w * r * gg.w);
            *(uint2*)(U + (size_t)m * DM + (lane + 64 * j) * 4) = o; }
    }
    { bf16_t* PB = (bf16_t*)(ws + WS_PB); const float4* p4 = (const float4*)a.p;
      for (int i = gid; i < T * PLE / 4; i += gsz) { const float4 v = p4[i]; uint2 o; o.x = pk2(v.x, v.y); o.y = pk2(v.z, v.w); *(uint2*)(PB + (size_t)i * 4) = o; } }
}
__device__ __forceinline__ void ph_rope(const Args& a) {
    bf16_t* Z = (bf16_t*)(a.ws + WS_Z); const float* tab = (const float*)(a.ws + WS_TAB); const float* ct = tab + 16384; const float* st = ct + T * 8;
    const size_t n = (size_t)T * 2 * 16 * 8;
    for (size_t i = (size_t)blockIdx.x * NTHR + threadIdx.x; i < n; i += (size_t)gridDim.x * NTHR) {
        const int j = i & 7, h = (i >> 3) & 15, qk = (i >> 7) & 1; const int m = (int)(i >> 8);
        bf16_t* p = Z + (size_t)m * INW + (qk ? C_K : C_Q) + h * 64 + j;
        const float x1 = bf2f(p[0]), x2 = bf2f(p[8]), c = ct[m * 8 + j], s = st[m * 8 + j];
        p[0] = (bf16_t)f2bf(x1 * c - x2 * s); p[8] = (bf16_t)f2bf(x2 * c + x1 * s);
    }
}
__device__ __forceinline__ void ph_attn_naive(const Args& a) {
    const bf16_t* Z = (const bf16_t*)(a.ws + WS_Z); bf16_t* Y = (bf16_t*)(a.ws + WS_R1);
    const int n = T * 16;
    for (int i = blockIdx.x * NTHR + threadIdx.x; i < n; i += gridDim.x * NTHR) {
        const int h = i & 15, m = i >> 4, b = m / SEQ, s = m % SEQ;
        float q[64], o[64]; const bf16_t* qp = Z + (size_t)m * INW + C_Q + h * 64;
#pragma unroll
        for (int d = 0; d < 64; ++d) { q[d] = bf2f(qp[d]) * 0.125f; o[d] = 0.f; }
        float mx = -1e30f, l = 0.f;
        for (int g = 0; g < 3; ++g) { const int dil = (g == 0) ? 1 : (g == 1 ? 4 : 16);
            for (int mm = -64; mm <= 64; ++mm) { const int j = s + dil * mm; if (j < 0 || j >= SEQ) continue;
                const bf16_t* kp = Z + (size_t)(b * SEQ + j) * INW + C_K + h * 64; const bf16_t* vp = kp + (C_V - C_K);
                float sc = 0.f;
#pragma unroll
                for (int d = 0; d < 64; ++d) sc += q[d] * bf2f(kp[d]);
                const float mn = fmaxf(mx, sc), f = __expf(mx - mn), p = __expf(sc - mn);
                l = l * f + p; mx = mn;
#pragma unroll
                for (int d = 0; d < 64; ++d) o[d] = o[d] * f + p * bf2f(vp[d]);
            } }
        const float il = 1.f / l; const bf16_t* gp = Z + (size_t)m * INW + C_AG + h * 64; bf16_t* yp = Y + (size_t)m * DM + h * 64;
#pragma unroll
        for (int d = 0; d < 64; ++d) yp[d] = (bf16_t)f2bf(o[d] * il * siluf_(bf2f(gp[d])));
    }
}
__device__ __forceinline__ void ph_hgrn_naive(const Args& a, LAS unsigned char* lds) {
    if (blockIdx.x >= 64) return;
    const bf16_t* Z = (const bf16_t*)(a.ws + WS_Z); const float* tab = (const float*)(a.ws + WS_TAB);
    LAS float* qs = (LAS float*)lds; LAS float* fs = qs + 16 * 128; LAS float* vs = fs + 16 * 128;
    const int dir = blockIdx.x & 1, h = (blockIdx.x >> 1) & 7, b = blockIdx.x >> 4, v = threadIdx.x & 127; const bool act = threadIdx.x < 128;
    const float lb = tab[dir * 1024 + h * 128 + v];
    float S[128];
#pragma unroll
    for (int k = 0; k < 128; ++k) S[k] = 0.f;
    bf16_t* O = (bf16_t*)(a.ws + (dir ? WS_OB : WS_OF));
    for (int c0 = 0; c0 < SEQ; c0 += 16) {
        __syncthreads();
        if (act) for (int tt = 0; tt < 16; ++tt) { const int s = dir ? (SEQ - 1 - (c0 + tt)) : (c0 + tt); const bf16_t* zr = Z + (size_t)(b * SEQ + s) * INW;
            qs[tt * 128 + v] = siluf_(bf2f(zr[C_HQ + h * 128 + v]));
            fs[tt * 128 + v] = lb + (1.f - lb) * sigmoidf_(bf2f(zr[(dir ? C_FB : C_FF) + h * 128 + v]));
            vs[tt * 128 + v] = bf2f(zr[C_HV + h * 128 + v]); }
        __syncthreads();
        if (act) for (int tt = 0; tt < 16; ++tt) { const float vv = vs[tt * 128 + v]; float o = 0.f;
#pragma unroll
            for (int k = 0; k < 128; ++k) { const float f = fs[tt * 128 + k]; S[k] = f * S[k] + (1.f - f) * vv; o += S[k] * qs[tt * 128 + k]; }
            const int s = dir ? (SEQ - 1 - (c0 + tt)) : (c0 + tt);
            O[(size_t)(b * SEQ + s) * 1024 + h * 128 + v] = (bf16_t)f2bf(o); }
    }
}
__device__ __forceinline__ void ph_combine(const Args& a) {
    const bf16_t* Z = (const bf16_t*)(a.ws + WS_Z); const bf16_t* OF = (const bf16_t*)(a.ws + WS_OF); const bf16_t* OB = (const bf16_t*)(a.ws + WS_OB); bf16_t* Y = (bf16_t*)(a.ws + WS_R1);
    const int lane = threadIdx.x & 63, gw = blockIdx.x * NWAVES + (threadIdx.x >> 6), nw = gridDim.x * NWAVES;
    for (int i = gw; i < T * 8; i += nw) { const int m = i >> 3, h = i & 7; const size_t o = (size_t)m * 1024 + h * 128;
        const float a0 = bf2f(OF[o + lane]) + bf2f(OB[o + lane]), a1 = bf2f(OF[o + 64 + lane]) + bf2f(OB[o + 64 + lane]);
        const float r = rsqrtf(wave_sum(a0 * a0 + a1 * a1) * (1.f / 128.f) + EPS);
        const bf16_t* gp = Z + (size_t)m * INW + C_HG + h * 128;
        Y[(size_t)m * DM + 1024 + h * 128 + lane] = (bf16_t)f2bf(a0 * r * a.g_hg[lane] * siluf_(bf2f(gp[lane])));
        Y[(size_t)m * DM + 1024 + h * 128 + 64 + lane] = (bf16_t)f2bf(a1 * r * a.g_hg[64 + lane] * siluf_(bf2f(gp[64 + lane]))); }
}
__device__ __forceinline__ void ph_h1(const Args& a) {
    const float* y2 = (const float*)(a.ws + WS_Z); bf16_t* h1b = (bf16_t*)(a.ws + WS_R1);
    const int lane = threadIdx.x & 63, gw = blockIdx.x * NWAVES + (threadIdx.x >> 6), nw = gridDim.x * NWAVES;
    for (int m = gw; m < T; m += nw) {
        const float4* yr = (const float4*)(y2 + (size_t)m * DM); float4 v[8]; float s = 0.f;
#pragma unroll
        for (int j = 0; j < 8; ++j) { v[j] = yr[lane + 64 * j]; s += v[j].x * v[j].x + v[j].y * v[j].y + v[j].z * v[j].z + v[j].w * v[j].w; }
        const float r = rsqrtf(wave_sum(s) * (1.f / DM) + EPS);
#pragma unroll
        for (int j = 0; j < 8; ++j) { const int c4 = lane + 64 * j; const float4 gg = ((const float4*)a.g_post)[c4], xx = ((const float4*)(a.x + (size_t)m * DM))[c4];
            float4 hh; hh.x = xx.x + v[j].x * r * gg.x; hh.y = xx.y + v[j].y * r * gg.y; hh.z = xx.z + v[j].z * r * gg.z; hh.w = xx.w + v[j].w * r * gg.w;
            ((float4*)(a.out + (size_t)m * DM))[c4] = hh; uint2 o; o.x = pk2(hh.x, hh.y); o.y = pk2(hh.z, hh.w); *(uint2*)(h1b + (size_t)m * DM + c4 * 4) = o; }
    }
}
__device__ __forceinline__ void ph_final(const Args& a) {
    const float* G = (const float*)(a.ws + WS_Z); const float* E = (const float*)(a.ws + WS_Z + 128 * MiB);
    const int lane = threadIdx.x & 63, gw = blockIdx.x * NWAVES + (threadIdx.x >> 6), nw = gridDim.x * NWAVES;
    for (int m = gw; m < T; m += nw) {
        float4 v[8]; float s = 0.f;
#pragma unroll
        for (int j = 0; j < 8; ++j) { const float4 g = ((const float4*)(G + (size_t)m * DM))[lane + 64 * j], e = ((const float4*)(E + (size_t)m * DM))[lane + 64 * j];
            v[j].x = sigmoidf_(g.x) * e.x; v[j].y = sigmoidf_(g.y) * e.y; v[j].z = sigmoidf_(g.z) * e.z; v[j].w = sigmoidf_(g.w) * e.w;
            s += v[j].x * v[j].x + v[j].y * v[j].y + v[j].z * v[j].z + v[j].w * v[j].w; }
        const float r = rsqrtf(wave_sum(s) * (1.f / DM) + EPS);
#pragma unroll
        for (int j = 0; j < 8; ++j) { const int c4 = lane + 64 * j; const float4 gg = ((const float4*)a.g_ple)[c4]; float4 hh = ((float4*)(a.out + (size_t)m * DM))[c4];
            hh.x += v[j].x * r * gg.x; hh.y += v[j].y * r * gg.y; hh.z += v[j].z * r * gg.z; hh.w += v[j].w * r * gg.w; ((float4*)(a.out + (size_t)m * DM))[c4] = hh; }
    }
}
__global__ void __launch_bounds__(NTHR, 2) mega_fwd(Args a) {
    extern __shared__ __attribute__((aligned(16))) unsigned char lds_raw[];
    LAS unsigned char* lds = (LAS unsigned char*)lds_raw;
    cg::grid_group grid = cg::this_grid();
    unsigned char* ws = a.ws;
    const int lo = a.ph_lo, hi = a.ph_hi;
#define IN(k) (lo <= (k) && (k) < hi)
#define SEAM(k) do { if (IN(k) && IN((k) + 1)) grid.sync(); } while (0)
    if (IN(0)) { p0_prologue(a, lds); __syncthreads(); }
    SEAM(0);
    if (IN(1)) { pg8::Gemm g{(const bf16_t*)(ws + WS_R1), (const bf16_t*)(ws + WS_WIN), T, INW, DM}; pg8::StaticOrder S; S.init(T, INW, gridDim.x, blockIdx.x);
        pg8::EpiBf16<0> E{(bf16_t*)(ws + WS_Z), INW, nullptr, 0, 0, 1.f};
        pg8::gemm_phase<pg8::EpiBf16<0>, pg8::StaticOrder, true, true>(lds, g, S, E); }
    SEAM(1);
    if (IN(2)) ph_rope(a);
    SEAM(2);
    if (IN(3)) { ph_hgrn_naive(a, lds); ph_attn_naive(a); }
    SEAM(3);
    if (IN(4)) ph_combine(a);
    SEAM(4);
    if (IN(5)) { pg8::Gemm g{(const bf16_t*)(ws + WS_R1), (const bf16_t*)(ws + WS_WOUT), T, DM, DM}; pg8::StaticOrder S; S.init(T, DM, gridDim.x, blockIdx.x);
        pg8::EpiF32 E{(float*)(ws + WS_Z), DM};
        pg8::gemm_phase<pg8::EpiF32, pg8::StaticOrder, true, true>(lds, g, S, E); }
    SEAM(5);
    if (IN(6)) ph_h1(a);
    SEAM(6);
    if (IN(7)) {
        { pg8::Gemm g{(const bf16_t*)(ws + WS_R1), (const bf16_t*)(ws + WS_WPG), T, DM, DM}; pg8::StaticOrder S; S.init(T, DM, gridDim.x, blockIdx.x);
          pg8::EpiF32 E{(float*)(ws + WS_Z), DM};
          pg8::gemm_phase<pg8::EpiF32, pg8::StaticOrder, true, true>(lds, g, S, E); }
        __syncthreads();
        { pg8::Gemm g{(const bf16_t*)(ws + WS_PB), (const bf16_t*)(ws + WS_WPP), T, DM, PLE}; pg8::StaticOrder S; S.init(T, DM, gridDim.x, blockIdx.x);
          pg8::EpiF32 E{(float*)(ws + WS_Z + 128 * MiB), DM};
          pg8::gemm_phase<pg8::EpiF32, pg8::StaticOrder, true, true>(lds, g, S, E); }
    }
    SEAM(7);
    if (IN(8)) ph_final(a);
#undef IN
#undef SEAM
}
constexpr int N_PHASES = 9;
#ifndef MK_SPLIT
#define MK_SPLIT 0
#endif
extern "C" void kernel_launch(void* const* d_in, const int* in_sizes, int n_in, void* d_out, int out_size, void* d_ws, size_t ws_size, hipStream_t stream) {
    static int grid = 0;
    if (grid == 0) {
        if (n_in != 13 || in_sizes[0] != T * DM || out_size != T * DM || ws_size < WS_END) { fprintf(stderr, "kernel_launch: unexpected shapes n_in %d in0 %d out %d ws %zu (need %zu)\n", n_in, n_in > 0 ? in_sizes[0] : -1, out_size, ws_size, (size_t)WS_END); grid = -1; return; }
        int dev = 0, cus = 0, per_cu = 0;
        if (hipGetDevice(&dev) != hipSuccess || hipDeviceGetAttribute(&cus, hipDeviceAttributeMultiprocessorCount, dev) != hipSuccess) { grid = -1; return; }
        if (hipFuncSetAttribute((const void*)mega_fwd, hipFuncAttributeMaxDynamicSharedMemorySize, LDS_BYTES) != hipSuccess) { fprintf(stderr, "kernel_launch: hipFuncSetAttribute failed\n"); grid = -1; return; }
        if (hipOccupancyMaxActiveBlocksPerMultiprocessor(&per_cu, (const void*)mega_fwd, NTHR, LDS_BYTES) != hipSuccess || per_cu < 1) { fprintf(stderr, "kernel_launch: occupancy query says %d blocks per CU\n", per_cu); (void)hipGetLastError(); grid = -1; return; }
        grid = cus * (per_cu > 1 ? 1 : per_cu);
        fprintf(stderr, "kernel_launch: %d CUs, %d blocks/CU admitted, grid %d, ws %zu\n", cus, per_cu, grid, ws_size);
    }
    if (grid < 0) return;
    Args a{};
    a.x = (const float*)d_in[0]; a.p = (const float*)d_in[1]; a.pos = (const int*)d_in[2]; a.w_in = (const float*)d_in[3]; a.w_out = (const float*)d_in[4];
    a.g_pre = (const float*)d_in[5]; a.g_post = (const float*)d_in[6]; a.g_hg = (const float*)d_in[7]; a.lb_fwd = (const float*)d_in[8]; a.lb_bwd = (const float*)d_in[9];
    a.w_pg = (const float*)d_in[10]; a.w_pp = (const float*)d_in[11]; a.g_ple = (const float*)d_in[12]; a.out = (float*)d_out; a.ws = (unsigned char*)d_ws;
    const int nl = MK_SPLIT ? N_PHASES : 1;
    for (int li = 0; li < nl; ++li) {
        a.ph_lo = MK_SPLIT ? li : 0; a.ph_hi = MK_SPLIT ? li + 1 : N_PHASES;
        void* args[] = {&a};
        hipError_t e = hipLaunchCooperativeKernel((const void*)mega_fwd, dim3(grid), dim3(NTHR), args, LDS_BYTES, stream);
        if (e != hipSuccess) { fprintf(stderr, "kernel_launch: cooperative launch failed: %s (grid %d)\n", hipGetErrorString(e), grid); break; }
    }
}
```

```cpp
#include <hip/hip_runtime.h>
#include <hip/hip_cooperative_groups.h>
#include <cstdio>
#include <cstdint>
namespace cg = cooperative_groups;
namespace pg8 {
#define PG8_LAS __attribute__((address_space(3)))
typedef unsigned short bf16_t;
typedef short bf16x8 __attribute__((ext_vector_type(8)));
typedef float f32x4 __attribute__((ext_vector_type(4)));
typedef unsigned u32x4 __attribute__((ext_vector_type(4)));
constexpr int BM = 256, BK = 64, HALF = 128, HTB = HALF * BK * 2  , STAGE_BYTES = 8 * HTB, NXCD = 8, WGM = 8;

__host__ __device__ __forceinline__ int lds_byte(int r, int c) { const int st = (r >> 4) * 2 + (c >> 5), rr = r & 15, cc = c & 31, ob = rr * 64 + cc * 2; return st * 1024 + (ob ^ (((ob >> 9) & 1) << 5)); }
__host__ __device__ __forceinline__ void stage_rc(int b, int& R, int& C) { const int st = b / 1024, sb = b % 1024, swz = sb ^ (((sb >> 9) & 1) << 5); R = (st >> 1) * 16 + swz / 64; C = (st & 1) * 32 + (swz % 64) / 2; }
__host__ __device__ __forceinline__ int perm32(int rho) { const int n = rho >> 4, i = rho & 15; return 8 * (i >> 2) + 4 * n + (i & 3); }

struct Unit { int pm, pn; };
struct Gemm { const bf16_t* A; const bf16_t* Bt; int M, N, K; };

struct StaticOrder {
    int nM, nN, nwg, G, c;
    __host__ __device__ void init(int M, int N, int G_, int c_) { nM = M / BM; nN = N / BM; nwg = nM * nN; G = G_; c = c_; }
    __host__ __device__ bool next(int i, Unit& u) const {
        const long L = (long)i * G + c; if (L >= nwg) return false;
        int wgid = (int)L; { const int q = nwg / NXCD, r = nwg % NXCD, xcd = wgid % NXCD, off = wgid / NXCD; wgid = (xcd < r ? xcd * (q + 1) : r * (q + 1) + (xcd - r) * q) + off; }
        const int nig = WGM * nN, gid = wgid / nig, fm = gid * WGM, gsz = (nM - fm) < WGM ? (nM - fm) : WGM;
        u.pm = fm + ((wgid % nig) % gsz); u.pn = (wgid % nig) / gsz; return true;
    }
    __device__ __forceinline__ void a_ready(const Unit&) const {}
    __device__ __forceinline__ void done(const Unit&) const {}
};

__device__ __forceinline__ unsigned cvt_pk_bf16(float lo, float hi) { unsigned r; asm volatile("v_cvt_pk_bf16_f32 %0, %1, %2" : "=v"(r) : "v"(lo), "v"(hi)); return r; }
typedef float f32x2 __attribute__((ext_vector_type(2)));
__device__ __forceinline__ f32x2 gelu_pk(f32x2 v) {
    const f32x2 av = __builtin_elementwise_abs(v), d = av * 0.2316418882f + 1.0f;
    f32x2 t; t.x = __builtin_amdgcn_rcpf(d.x); t.y = __builtin_amdgcn_rcpf(d.y);
    f32x2 q = t * 0.5307027145f + (-0.7265760135f); q = q * t + 0.7107068705f; q = q * t + (-0.142248368f); q = q * t + 0.127414796f; q = q * t;
    const f32x2 s = (v * v) * (-0.72134752044f);
    f32x2 e; e.x = __builtin_amdgcn_exp2f(s.x); e.y = __builtin_amdgcn_exp2f(s.y);
    const f32x2 m = v * (q * e), r = v - m;
    f32x2 o; o.x = v.x < 0.f ? m.x : r.x; o.y = v.y < 0.f ? m.y : r.y; return o;
}

template <int ACT  > struct EpiBf16 {
    static constexpr bool PERM = true, AFTER_DRAIN = false; static_assert(ACT == 0 || ACT == 1, "EpiBf16: ACT is 0 (none) or 1 (gelu_pk)");
    bf16_t* O; int ldc; const float* bias; int split_cols; size_t split_stride; float scale0;
    __device__ __forceinline__ void operator()(const f32x4 (&acc)[2][2][4][2], const Unit& u, int wr, int wc, int fr, int fq) const {
        const int row0 = u.pm * BM + wr * 64 + fr; int colt = u.pn * BM; bf16_t* base = O;
        float sc = 1.f; if (split_cols) { const int t = colt / split_cols; base += (size_t)t * split_stride; colt -= t * split_cols; if (t == 0) sc = scale0; }
        const int col0 = colt + wc * 32 + 8 * fq, bcol0 = u.pn * BM + wc * 32 + 8 * fq;
        f32x4 bv[2][2];
#pragma unroll
        for (int bj = 0; bj < 2; ++bj)
#pragma unroll
            for (int n = 0; n < 2; ++n) bv[bj][n] = bias ? *(const f32x4*)(bias + bcol0 + bj * HALF + 4 * n) : (f32x4){0.f, 0.f, 0.f, 0.f};
#pragma unroll
        for (int ai = 0; ai < 2; ++ai)
#pragma unroll
            for (int m = 0; m < 4; ++m) { bf16_t* rowp = base + (size_t)(row0 + ai * HALF + m * 16) * ldc + col0;
#pragma unroll
                for (int bj = 0; bj < 2; ++bj) { f32x4 v0 = acc[ai][bj][m][0] + bv[bj][0], v1 = acc[ai][bj][m][1] + bv[bj][1];
                    if (ACT == 1) { f32x2 a = gelu_pk((f32x2){v0[0], v0[1]}), b = gelu_pk((f32x2){v0[2], v0[3]}), c = gelu_pk((f32x2){v1[0], v1[1]}), d = gelu_pk((f32x2){v1[2], v1[3]});
                        v0 = (f32x4){a.x, a.y, b.x, b.y}; v1 = (f32x4){c.x, c.y, d.x, d.y}; }
                    v0 = v0 * sc; v1 = v1 * sc; u32x4 w; w.x = cvt_pk_bf16(v0[0], v0[1]); w.y = cvt_pk_bf16(v0[2], v0[3]); w.z = cvt_pk_bf16(v1[0], v1[1]); w.w = cvt_pk_bf16(v1[2], v1[3]);
                    *(u32x4*)(rowp + bj * HALF) = w; } }
    }
};
struct EpiF32 {
    static constexpr bool PERM = false, AFTER_DRAIN = false;
    float* O; int ldc;
    __device__ __forceinline__ void operator()(const f32x4 (&acc)[2][2][4][2], const Unit& u, int wr, int wc, int fr, int fq) const {
        const int col0 = u.pn * BM + wc * 32 + 4 * fq;
#pragma unroll
        for (int ai = 0; ai < 2; ++ai)
#pragma unroll
            for (int m = 0; m < 4; ++m) { float* rowp = O + (size_t)(u.pm * BM + ai * HALF + wr * 64 + m * 16 + fr) * ldc + col0;
#pragma unroll
                for (int bj = 0; bj < 2; ++bj)
#pragma unroll
                    for (int n = 0; n < 2; ++n) *(f32x4*)(rowp + bj * HALF + n * 16) = acc[ai][bj][m][n]; }
    }
};

template <class Epi, class Sched, bool ALIGN_EPI = false, bool SP2 = false>
__device__ __forceinline__ void gemm_phase(PG8_LAS unsigned char* lds, const Gemm g, const Sched& S, const Epi& E) {
    const int tid = threadIdx.x, wid = __builtin_amdgcn_readfirstlane(tid >> 6), lane = tid & 63, wr = wid >> 2, wc = wid & 3, fr = lane & 15, fq = lane >> 4;
    const int K = g.K, nt = K / BK;
    unsigned voffA[2], voffB[2];
#pragma unroll
    for (int i = 0; i < 2; ++i) { int R, C; stage_rc(tid * 16 + i * 8192, R, C); const int Rb = Epi::PERM ? ((R & ~31) + perm32(R & 31)) : R;
        voffA[i] = (unsigned)(R * K + C) * 2u; voffB[i] = (unsigned)(Rb * K + C) * 2u; }
    const size_t kstep = (size_t)(BK * 2);
    const size_t hstep = (size_t)HALF * K * 2;
    const size_t tstep = 2 * hstep;
    const unsigned ldsw = (unsigned)wid * 1024u;
    const int aoff = lds_byte(wr * 64 + fr, fq * 8), boff = lds_byte(wc * 32 + fr, fq * 8);
#define PG8_SA(b, h) (((b) * 2 + (h)) * HTB)
#define PG8_SB(b, h) ((4 + (b) * 2 + (h)) * HTB)
#define PG8_STAGE(bufoff, gbase, voff) do { _Pragma("unroll") for (int _i = 0; _i < 2; ++_i) \
        __builtin_amdgcn_global_load_lds((const unsigned*)((const char*)(gbase) + (voff)[_i]), (PG8_LAS unsigned*)(lds + (bufoff) + ldsw + _i * 8192), 16, 0, 0); } while (0)
#define PG8_LDA(dst, b, h) do { _Pragma("unroll") for (int m = 0; m < 4; ++m) _Pragma("unroll") for (int k = 0; k < 2; ++k) dst[m][k] = *(const PG8_LAS bf16x8*)(lds + PG8_SA(b, h) + aoff + m * 2048 + k * 1024); } while (0)
#define PG8_LDB(dst, b, h) do { _Pragma("unroll") for (int n = 0; n < 2; ++n) _Pragma("unroll") for (int k = 0; k < 2; ++k) dst[n][k] = *(const PG8_LAS bf16x8*)(lds + PG8_SB(b, h) + boff + n * 2048 + k * 1024); } while (0)
#define PG8_MMA(ai, bj, At, Bt) do { __builtin_amdgcn_s_setprio(1); _Pragma("unroll") for (int m = 0; m < 4; ++m) _Pragma("unroll") for (int n = 0; n < 2; ++n) _Pragma("unroll") for (int k = 0; k < 2; ++k) \
        acc[ai][bj][m][n] = __builtin_amdgcn_mfma_f32_16x16x32_bf16(Bt[n][k], At[m][k], acc[ai][bj][m][n], 0, 0, 0); __builtin_amdgcn_s_setprio(0); } while (0)
#define PG8_WAIT_V(n) asm volatile("s_waitcnt vmcnt(" #n ")" ::: "memory")
#define PG8_WAIT_L(n) asm volatile("s_waitcnt lgkmcnt(" #n ")" ::: "memory")
#define PG8_BAR __builtin_amdgcn_s_barrier()
#define PG8_SCHED __builtin_amdgcn_sched_barrier(0)
    Unit cur, nxt; int ui = 0;
    if (!S.next(0, cur)) return;
    f32x4 acc[2][2][4][2];
#pragma unroll
    for (int a = 0; a < 2; ++a)
#pragma unroll
        for (int b = 0; b < 2; ++b)
#pragma unroll
            for (int m = 0; m < 4; ++m)
#pragma unroll
                for (int n = 0; n < 2; ++n) acc[a][b][m][n] = (f32x4){0.f, 0.f, 0.f, 0.f};
    bf16x8 At[4][2], B0[2][2], B1[2][2];
    const char* cA = (const char*)g.A + (size_t)cur.pm * tstep; const char* cB = (const char*)g.Bt + (size_t)cur.pn * tstep;
    S.a_ready(cur);
    if constexpr (SP2) {
        PG8_STAGE(PG8_SB(0, 0), cB, voffB); PG8_STAGE(PG8_SB(0, 1), cB + hstep, voffB); PG8_STAGE(PG8_SA(0, 0), cA, voffA); PG8_STAGE(PG8_SA(0, 1), cA + hstep, voffA);
        if (wr == 1) PG8_BAR;
        PG8_WAIT_V(2); PG8_BAR;
        PG8_STAGE(PG8_SB(1, 0), cB + kstep, voffB); PG8_STAGE(PG8_SA(1, 0), cA + kstep, voffA); PG8_STAGE(PG8_SB(1, 1), cB + hstep + kstep, voffB);
        PG8_WAIT_V(6); PG8_BAR;
    } else {
        PG8_STAGE(PG8_SB(0, 0), cB, voffB); PG8_STAGE(PG8_SA(0, 0), cA, voffA); PG8_STAGE(PG8_SB(0, 1), cB + hstep, voffB); PG8_STAGE(PG8_SA(0, 1), cA + hstep, voffA);
        if (wr == 1) PG8_BAR;
        PG8_WAIT_V(4); PG8_BAR;
        PG8_STAGE(PG8_SB(1, 0), cB + kstep, voffB); PG8_STAGE(PG8_SA(1, 0), cA + kstep, voffA); PG8_STAGE(PG8_SB(1, 1), cB + hstep + kstep, voffB);
        PG8_WAIT_V(6); PG8_BAR;
    }
    for (;;) {
        const bool has_next = S.next(ui + 1, nxt);
        const char* nA = has_next ? (const char*)g.A + (size_t)nxt.pm * tstep : cA; const char* nB = has_next ? (const char*)g.Bt + (size_t)nxt.pn * tstep : cB;
        for (int t = 0; t < nt; t += 2) {
            const bool last = (t == nt - 2);
            const char* a1 = cA + (size_t)(t + 1) * kstep;
            const char* a2 = last ? nA : cA + (size_t)(t + 2) * kstep; const char* b2 = last ? nB : cB + (size_t)(t + 2) * kstep;
            const char* a3 = a2 + kstep; const char* b3 = b2 + kstep;
            if (last && has_next) S.a_ready(nxt);
            if constexpr (SP2) {
            PG8_LDB(B0, 0, 0); PG8_LDB(B1, 0, 1); PG8_SCHED; PG8_LDA(At, 0, 0); PG8_STAGE(PG8_SA(1, 1), a1 + hstep, voffA);
            PG8_WAIT_V(8); PG8_WAIT_L(0); PG8_BAR; PG8_MMA(0, 0, At, B0); PG8_MMA(0, 1, At, B1); PG8_BAR; PG8_SCHED;
            PG8_LDA(At, 0, 1); PG8_STAGE(PG8_SB(0, 0), b2, voffB); PG8_STAGE(PG8_SB(0, 1), b2 + hstep, voffB); PG8_STAGE(PG8_SA(0, 0), a2, voffA);
            PG8_WAIT_V(8); PG8_WAIT_L(0); PG8_BAR; PG8_MMA(1, 0, At, B0); PG8_MMA(1, 1, At, B1); PG8_BAR; PG8_SCHED;
            PG8_LDB(B0, 1, 0); PG8_LDB(B1, 1, 1); PG8_SCHED; PG8_LDA(At, 1, 0); PG8_STAGE(PG8_SA(0, 1), a2 + hstep, voffA);
            PG8_WAIT_V(8); PG8_WAIT_L(0); PG8_BAR; PG8_MMA(0, 0, At, B0); PG8_MMA(0, 1, At, B1); PG8_BAR; PG8_SCHED;
            PG8_LDA(At, 1, 1); PG8_STAGE(PG8_SB(1, 0), b3, voffB); PG8_STAGE(PG8_SB(1, 1), b3 + hstep, voffB); PG8_STAGE(PG8_SA(1, 0), a3, voffA);
            PG8_WAIT_V(8); PG8_WAIT_L(0); PG8_BAR; PG8_MMA(1, 0, At, B0); PG8_MMA(1, 1, At, B1); PG8_BAR; PG8_SCHED;
            } else {
            PG8_LDB(B0, 0, 0); PG8_SCHED; PG8_LDA(At, 0, 0); PG8_STAGE(PG8_SA(1, 1), a1 + hstep, voffA);
            PG8_WAIT_L(8); PG8_BAR; PG8_WAIT_L(0); PG8_MMA(0, 0, At, B0); PG8_BAR; PG8_SCHED;
            PG8_LDB(B1, 0, 1); PG8_STAGE(PG8_SB(0, 0), b2, voffB);
            PG8_BAR; PG8_WAIT_L(0); PG8_MMA(0, 1, At, B1); PG8_BAR;
            PG8_LDA(At, 0, 1); PG8_STAGE(PG8_SA(0, 0), a2, voffA);
            PG8_BAR; PG8_WAIT_L(0); PG8_MMA(1, 0, At, B0); PG8_BAR; PG8_SCHED;
            PG8_STAGE(PG8_SB(0, 1), b2 + hstep, voffB);
            PG8_WAIT_V(6); PG8_BAR; PG8_MMA(1, 1, At, B1); PG8_BAR;
            PG8_LDB(B0, 1, 0); PG8_SCHED; PG8_LDA(At, 1, 0); PG8_STAGE(PG8_SA(0, 1), a2 + hstep, voffA);
            PG8_WAIT_L(8); PG8_BAR; PG8_WAIT_L(0); PG8_MMA(0, 0, At, B0); PG8_BAR; PG8_SCHED;
            PG8_LDB(B1, 1, 1); PG8_STAGE(PG8_SB(1, 0), b3, voffB);
            PG8_BAR; PG8_WAIT_L(0); PG8_MMA(0, 1, At, B1); PG8_BAR;
            PG8_LDA(At, 1, 1); PG8_STAGE(PG8_SA(1, 0), a3, voffA);
            PG8_BAR; PG8_WAIT_L(0); PG8_MMA(1, 0, At, B0); PG8_BAR; PG8_SCHED;
            PG8_STAGE(PG8_SB(1, 1), b3 + hstep, voffB);
            PG8_WAIT_V(6); PG8_BAR; PG8_MMA(1, 1, At, B1); PG8_BAR;
            }
        }
        if constexpr (ALIGN_EPI) { if (wr == 0) PG8_BAR; }
        if constexpr (!Epi::AFTER_DRAIN) { E(acc, cur, wr, wc, fr, fq); S.done(cur); }
        if (!has_next) break;
#pragma unroll
        for (int a = 0; a < 2; ++a)
#pragma unroll
            for (int b = 0; b < 2; ++b)
#pragma unroll
                for (int m = 0; m < 4; ++m)
#pragma unroll
                    for (int n = 0; n < 2; ++n) acc[a][b][m][n] = (f32x4){0.f, 0.f, 0.f, 0.f};
        cur = nxt; cA = nA; cB = nB; ++ui;
        if constexpr (ALIGN_EPI) { if (wr == 1) PG8_BAR; }
    }
    PG8_WAIT_V(0);
    if constexpr (!ALIGN_EPI) { if (wr == 0) PG8_BAR; }
    PG8_BAR;
    if constexpr (Epi::AFTER_DRAIN) { E.fused(acc, cur, wr, wc, fr, fq, lds, wid, lane); S.done(cur); }
#undef PG8_SA
#undef PG8_SB
#undef PG8_STAGE
#undef PG8_LDA
#undef PG8_LDB
#undef PG8_MMA
#undef PG8_WAIT_V
#undef PG8_WAIT_L
#undef PG8_BAR
#undef PG8_SCHED
}
}

#ifndef PG8_SP2
#define PG8_SP2 true
#endif
#ifndef PG8_ALIGN
#define PG8_ALIGN true
#endif
typedef unsigned short bf16_t;
#define GAS __attribute__((address_space(1)))
#define LAS __attribute__((address_space(3)))
typedef unsigned v4u __attribute__((ext_vector_type(4)));
constexpr int NWAVES = 8, NTHR = 512;
constexpr int BATCH = 4, SEQ = 4096, T = BATCH * SEQ, DM = 2048, INW = 9216, PLE = 256;
constexpr int C_Q = 0, C_K = 1024, C_V = 2048, C_AG = 3072, C_HQ = 4096, C_FF = 5120, C_FB = 6144, C_HV = 7168, C_HG = 8192;
constexpr float EPS = 1e-6f;
constexpr size_t MiB = 1u << 20;
constexpr size_t WS_TAB = 0;
constexpr size_t WS_WIN = 2 * MiB;
constexpr size_t WS_WOUT = WS_WIN + 36 * MiB;
constexpr size_t WS_R1 = WS_WOUT + 8 * MiB;
constexpr size_t WS_Z = WS_R1 + 64 * MiB;
constexpr size_t WS_OF = WS_Z + 288 * MiB;
constexpr size_t WS_OB = WS_OF + 32 * MiB;
constexpr size_t WS_OG2 = WS_OB + 32 * MiB;
constexpr size_t WS_LSE = WS_OG2 + 32 * MiB;
constexpr size_t WS_END = WS_LSE + 3 * MiB;
constexpr size_t WS_WPG = WS_Z + 256 * MiB;
constexpr size_t WS_WPP = WS_WPG + 8 * MiB;
constexpr size_t WS_PB = WS_WPP + 1 * MiB;
constexpr int LDS_BYTES = 147456;

__device__ __forceinline__ float bf2f(bf16_t v) { return __uint_as_float(((unsigned)v) << 16); }
__device__ __forceinline__ unsigned f2bf(float f) { unsigned u = __float_as_uint(f); return (u + 0x7fffu + ((u >> 16) & 1u)) >> 16; }
__device__ __forceinline__ unsigned pk2(float lo, float hi) { return f2bf(lo) | (f2bf(hi) << 16); }
__device__ __forceinline__ float sigmoidf_(float x) { return 1.f / (1.f + __expf(-x)); }
__device__ __forceinline__ float siluf_(float x) { return x / (1.f + __expf(-x)); }
__device__ __forceinline__ float wave_sum(float v) {
#pragma unroll
    for (int o = 1; o < 64; o <<= 1) v += __shfl_xor(v, o);
    return v;
}
#define LDS_WAIT() asm volatile("s_waitcnt lgkmcnt(0)" ::: "memory")

struct Args {
    const float* x; const float* p; const int* pos; const float* w_in; const float* w_out; const float* g_pre; const float* g_post; const float* g_hg;
    const float* lb_fwd; const float* lb_bwd; const float* w_pg; const float* w_pp; const float* g_ple; float* out; unsigned char* ws; int ph_lo, ph_hi;
};

__constant__ float ROPE_INV[8] = {1.0f, 0.1939227432012558f, 0.03760603070259094f, 0.007292664609849453f, 0.0014142135623842478f, 0.00027424818836152554f, 5.318296098266728e-05f, 1.0313386155758053e-05f};
__device__ __forceinline__ void p0_transpose_item(const float* W, int K, int N, bf16_t* WT, LAS float* scr, int item, int lane) {
    const int nblk = N / 32, kb = item / nblk, nb = item % nblk, k0 = 64 * kb, n0 = 32 * nb;
#pragma unroll 8
    for (int i = 0; i < 32; ++i) { const int kk = 2 * i + (lane >> 5); scr[kk * 33 + (lane & 31)] = W[(size_t)(k0 + kk) * N + n0 + (lane & 31)]; }
    LDS_WAIT(); asm volatile("" ::: "memory");
    const int c = lane & 7;
#pragma unroll
    for (int j = 0; j < 4; ++j) { const int n = (lane >> 3) + 8 * j; const LAS float* s = scr + (8 * c) * 33 + n;
        v4u o; o.x = pk2(s[0 * 33], s[1 * 33]); o.y = pk2(s[2 * 33], s[3 * 33]); o.z = pk2(s[4 * 33], s[5 * 33]); o.w = pk2(s[6 * 33], s[7 * 33]);
        *(GAS v4u*)(WT + (size_t)(n0 + n) * K + k0 + 8 * c) = o; }
    LDS_WAIT(); asm volatile("" ::: "memory");
}
__device__ __forceinline__ void p0_prologue(const Args& a, LAS unsigned char* lds) {
    const int tid = threadIdx.x, lane = tid & 63, wave = tid >> 6;
    const int gw = blockIdx.x * NWAVES + wave, NGW = gridDim.x * NWAVES, gid = blockIdx.x * NTHR + tid, gsz = gridDim.x * NTHR;
    unsigned char* ws = a.ws; float* tab = (float*)(ws + WS_TAB);
    for (int i = gid; i < 2048; i += gsz) { const float* src = (i < 1024) ? a.lb_fwd : a.lb_bwd; const int k = i & 1023;
        const float a0 = src[k], a1 = src[1024 + k], m = fmaxf(a0, a1), e0 = __expf(a0 - m), e1 = __expf(a1 - m); tab[i] = e0 / (e0 + e1); }
    { float* ct = tab + 16384; float* st = ct + T * 8;
      for (int i = gid; i < T * 8; i += gsz) { const int m = i >> 3, j = i & 7; const float ang = (float)a.pos[m] * ROPE_INV[j];
        const double av = (double)ang, k = rint(av * 0.15915494309189535), r = fma(-k, 2.4492935982947064e-16, fma(-k, 6.283185307179586, av));
        const double r2 = r * r; double s = 0.0, c = 0.0, ts = 1.0, tc = 1.0;
#pragma unroll 1
        for (int n = 0; n < 14; ++n) { c += tc; s += ts; tc *= -r2 / (double)((2 * n + 1) * (2 * n + 2)); ts *= -r2 / (double)((2 * n + 2) * (2 * n + 3)); }
        ct[i] = (float)c; st[i] = (float)(s * r); } }
    LAS float* scr = (LAS float*)(lds + wave * 16384);
    constexpr int I_IN = (DM / 64) * (INW / 32), I_SQ = (DM / 64) * (DM / 32), NITEMS = I_IN + I_SQ;
    for (int it = gw; it < NITEMS; it += NGW) { int r = it;
        if (r < I_IN) { p0_transpose_item(a.w_in, DM, INW, (bf16_t*)(ws + WS_WIN), scr, r, lane); continue; } r -= I_IN;
        p0_transpose_item(a.w_out, DM, DM, (bf16_t*)(ws + WS_WOUT), scr, r, lane); }
    bf16_t* U = (bf16_t*)(ws + WS_R1);
    for (int m = gw; m < T; m += NGW) {
        const float4* xr = (const float4*)(a.x + (size_t)m * DM); float4 v[8]; float s = 0.f;
#pragma unroll
        for (int j = 0; j < 8; ++j) { v[j] = xr[lane + 64 * j]; s += v[j].x * v[j].x + v[j].y * v[j].y + v[j].z * v[j].z + v[j].w * v[j].w; }
        const float r = rsqrtf(wave_sum(s) * (1.f / DM) + EPS);
#pragma unroll
        for (int j = 0; j < 8; ++j) { const float4 gg = ((const float4*)a.g_pre)[lane + 64 * j];
            uint2 o; o.x = pk2(v[j].x * r * gg.x, v[j].y * r * gg.y); o.y = pk2(v[j].z * r * gg.z, v[j].w * r * gg.w);
            *(uint2*)(U + (size_t)m * DM + (lane + 64 * j) * 4) = o; }
    }
}
__device__ __forceinline__ void p_late_convert(const Args& a, LAS unsigned char* lds) {
    const int tid = threadIdx.x, lane = tid & 63, wave = tid >> 6;
    const int gw = blockIdx.x * NWAVES + wave, NGW = gridDim.x * NWAVES, gid = blockIdx.x * NTHR + tid, gsz = gridDim.x * NTHR;
    unsigned char* ws = a.ws; LAS float* scr = (LAS float*)(lds + wave * 16384);
    constexpr int I_SQ = (DM / 64) * (DM / 32), I_PP = (PLE / 64) * (DM / 32), NITEMS = I_SQ + I_PP;
    for (int it = gw; it < NITEMS; it += NGW) { int r = it;
        if (r < I_SQ) { p0_transpose_item(a.w_pg, DM, DM, (bf16_t*)(ws + WS_WPG), scr, r, lane); continue; } r -= I_SQ;
        p0_transpose_item(a.w_pp, PLE, DM, (bf16_t*)(ws + WS_WPP), scr, r, lane); }
    { bf16_t* PB = (bf16_t*)(ws + WS_PB); const float4* p4 = (const float4*)a.p;
      for (int i = gid; i < T * PLE / 4; i += gsz) { const float4 v = p4[i]; uint2 o; o.x = pk2(v.x, v.y); o.y = pk2(v.z, v.w); *(uint2*)(PB + (size_t)i * 4) = o; } }
}
namespace att {
typedef float f32x16 __attribute__((ext_vector_type(16)));
typedef short bf16x8 __attribute__((ext_vector_type(8)));
typedef short s16x4 __attribute__((ext_vector_type(4)));
typedef short v4i16_t __attribute__((ext_vector_type(4)));
typedef float f32x2_t __attribute__((ext_vector_type(2))); typedef __bf16 bf16x2_t __attribute__((ext_vector_type(2)));
constexpr int NK = 384, LDS_K = 0, LDS_V = NK * 128, VHALF = NK * 64, LDS_TOTAL = LDS_V + 2 * VHALF;
__device__ __forceinline__ int crow(int r, int hi) { return (r & 3) + 8 * (r >> 2) + 4 * hi; }
__device__ __forceinline__ unsigned cvtpk(float lo, float hi) { f32x2_t v = {lo, hi}; bf16x2_t b = __builtin_convertvector(v, bf16x2_t); return __builtin_bit_cast(unsigned, b); }
__device__ __forceinline__ s16x4 vtr(const LAS unsigned char* p) { return __builtin_bit_cast(s16x4, __builtin_amdgcn_ds_read_tr16_b64_v4i16((LAS v4i16_t*)p)); }

__device__ __forceinline__ void attn_unit(LAS unsigned char* lds, const bf16_t* __restrict__ Z, bf16_t* __restrict__ Og, int og_pitch, float* __restrict__ LSEg, int g, int b, int h, int r, int blk) {
    const int tid = threadIdx.x, lane = tid & 63, wave = __builtin_amdgcn_readfirstlane(tid >> 6), r32 = lane & 31, hi = lane >> 5;
    const int d = (g == 0) ? 1 : (g == 1 ? 4 : 16), L = SEQ / d, ka0 = 256 * blk - 64;
    const bf16_t* Zb = Z + (size_t)(b * SEQ + r) * INW + h * 64;
#pragma unroll
    for (int ii = 0; ii < 6; ++ii) { const int i = wave * 6 + ii, row = 8 * i + (lane >> 3); int ka = ka0 + row; ka = ka < 0 ? 0 : (ka > L - 1 ? L - 1 : ka);
        const int c = (lane & 7) ^ ((row >> 1) & 7);
        __builtin_amdgcn_global_load_lds((const unsigned*)(Zb + (size_t)(d * ka) * INW + C_K + c * 8), (LAS unsigned*)(lds + LDS_K + i * 1024), 16, 0, 0); }
#pragma unroll
    for (int ii = 0; ii < 6; ++ii) { const int i = wave * 6 + ii, dh = i / 24, kg = i % 24, key = 16 * kg + (lane >> 2); int ka = ka0 + key; ka = ka < 0 ? 0 : (ka > L - 1 ? L - 1 : ka);
        __builtin_amdgcn_global_load_lds((const unsigned*)(Zb + (size_t)(d * ka) * INW + C_V + dh * 32 + (lane & 3) * 8), (LAS unsigned*)(lds + LDS_V + dh * VHALF + kg * 1024), 16, 0, 0); }
    const int a0 = 256 * blk + 32 * wave;
    bf16x8 qf[4];
    { const bf16_t* qp = Zb + (size_t)(d * (a0 + r32)) * INW + C_Q + 8 * hi;
#pragma unroll
      for (int d0 = 0; d0 < 4; ++d0) qf[d0] = *(const bf16x8*)(qp + 16 * d0); }
    asm volatile("s_waitcnt vmcnt(0)" ::: "memory");
    __syncthreads();
    f32x16 p[5];
#pragma unroll
    for (int t = 0; t < 5; ++t) { f32x16 acc = {};
        const int row = 32 * wave + 32 * t + r32; const LAS unsigned char* kb = lds + LDS_K + row * 128; const int sw = (row >> 1) & 7;
#pragma unroll
        for (int d0 = 0; d0 < 4; ++d0) { const bf16x8 kf = *(const LAS bf16x8*)(kb + (((2 * d0 + hi) ^ sw) << 4)); acc = __builtin_amdgcn_mfma_f32_32x32x16_bf16(kf, qf[d0], acc, 0, 0, 0); }
        p[t] = acc; }
    const float SC = 0.125f * 1.4426950408889634f, NEGINF = -__builtin_inff();
    float mx = NEGINF;
#pragma unroll
    for (int t = 0; t < 5; ++t)
#pragma unroll
        for (int rr = 0; rr < 16; ++rr) { const int kr = crow(rr, hi), ka = ka0 + 32 * wave + 32 * t + kr; bool valid = (ka >= 0) && (ka < L);
            if (t == 0) valid = valid && (kr >= r32); if (t == 4) valid = valid && (kr <= r32);
            const float s = valid ? p[t][rr] * SC : NEGINF; p[t][rr] = s; mx = fmaxf(mx, s); }
    mx = fmaxf(mx, __shfl_xor(mx, 32));
    float l = 0.f;
#pragma unroll
    for (int t = 0; t < 5; ++t)
#pragma unroll
        for (int rr = 0; rr < 16; ++rr) { const float e = __builtin_amdgcn_exp2f(p[t][rr] - mx); p[t][rr] = e; l += e; }
    l += __shfl_xor(l, 32);
    f32x16 o[2]; o[0] = f32x16{}; o[1] = f32x16{};
    const LAS unsigned char* vb = lds + LDS_V + (32 * wave + 4 * hi + ((lane & 15) >> 2)) * 64 + ((lane >> 4) & 1) * 32 + (lane & 3) * 8;
#pragma unroll
    for (int t = 0; t < 5; ++t)
#pragma unroll
        for (int s = 0; s < 2; ++s) {
            typedef unsigned u32x4 __attribute__((ext_vector_type(4)));
            u32x4 pw; pw.x = cvtpk(p[t][8 * s + 0], p[t][8 * s + 1]); pw.y = cvtpk(p[t][8 * s + 2], p[t][8 * s + 3]); pw.z = cvtpk(p[t][8 * s + 4], p[t][8 * s + 5]); pw.w = cvtpk(p[t][8 * s + 6], p[t][8 * s + 7]);
            const bf16x8 pa = __builtin_bit_cast(bf16x8, pw);
#pragma unroll
            for (int d0 = 0; d0 < 2; ++d0) { const LAS unsigned char* vp = vb + d0 * VHALF + (32 * t + 16 * s) * 64;
                const s16x4 lo = vtr(vp), hh = vtr(vp + 512);
                const bf16x8 vf = {lo[0], lo[1], lo[2], lo[3], hh[0], hh[1], hh[2], hh[3]};
                o[d0] = __builtin_amdgcn_mfma_f32_32x32x16_bf16(pa, vf, o[d0], 0, 0, 0); } }
    const float il = 1.f / l;
    if (hi == 0) LSEg[(size_t)(b * SEQ + r + d * (a0 + r32)) * 16 + h] = (mx + __log2f(l)) * 0.6931471805599453f;
#pragma unroll
    for (int rr = 0; rr < 16; ++rr) { const int q = crow(rr, hi); const float ilr = __shfl(il, q);
        bf16_t* op = Og + (size_t)(b * SEQ + r + d * (a0 + q)) * og_pitch + h * 64 + r32;
        op[0] = (bf16_t)f2bf(o[0][rr] * ilr); op[32] = (bf16_t)f2bf(o[1][rr] * ilr); }
    __syncthreads();
}
__device__ __forceinline__ void attn_phase(LAS unsigned char* lds, const Args& a, int vb, int nb) {
    const bf16_t* Z = (const bf16_t*)(a.ws + WS_Z); bf16_t* R1 = (bf16_t*)(a.ws + WS_R1); bf16_t* OG2 = (bf16_t*)(a.ws + WS_OG2); float* LSE = (float*)(a.ws + WS_LSE);
    const int xcd = blockIdx.x & 7;
    for (int bhi = 0; bhi < 8; ++bhi) { const int bh = xcd * 8 + bhi, b = bh >> 4, h = bh & 15;
        for (int u = vb; u < 48; u += nb) { const int g = u >> 4, k = u & 15;
            const int r = (g == 0) ? 0 : (g == 1 ? (k & 3) : k), blk = (g == 0) ? k : (g == 1 ? (k >> 2) : 0);
            bf16_t* Og = (g == 0) ? R1 : (g == 1 ? R1 + 1024 : OG2); const int pitch = (g == 2) ? 1024 : 2048;
            attn_unit(lds, Z, Og, pitch, LSE + (size_t)g * T * 16, g, b, h, r, blk); } }
}
}
namespace hg {
typedef float f32x2v __attribute__((ext_vector_type(2)));
using att::f32x16; using att::bf16x8; using att::s16x4; using att::vtr; using att::crow; using att::cvtpk;
constexpr int QS = 272, K2S = 320;
constexpr int L_QT = 0, L_KT1 = L_QT + 64 * QS, L_KT2 = L_KT1 + 64 * QS, L_V = L_KT2 + 64 * K2S, L_S = L_V + 4 * 64 * 64, L_TOT = L_S + 4 * 128 * 64, L_EL = L_TOT + 8 * 128 * 4, L_END = L_EL + 512;
__device__ __forceinline__ bf16x8 frag_tr_nat(const LAS unsigned char* base, int stride, int kb, int n0, int lane) {
    const int g4 = lane >> 4, i = lane & 15; const LAS unsigned char* p = base + (kb + 8 * (g4 >> 1) + (i >> 2)) * stride + (n0 + 16 * (g4 & 1) + 4 * (i & 3)) * 2;
    const s16x4 lo = vtr(p), hh = vtr(p + 4 * stride); return (bf16x8){lo[0], lo[1], lo[2], lo[3], hh[0], hh[1], hh[2], hh[3]};
}
__device__ __forceinline__ bf16x8 frag_tr_perm(const LAS unsigned char* base, int stride, int kb, int n0, int lane) {
    const int g4 = lane >> 4, i = lane & 15; const LAS unsigned char* p = base + (kb + 4 * (g4 >> 1) + (i >> 2)) * stride + (n0 + 16 * (g4 & 1) + 4 * (i & 3)) * 2;
    const s16x4 lo = vtr(p), hh = vtr(p + 8 * stride); return (bf16x8){lo[0], lo[1], lo[2], lo[3], hh[0], hh[1], hh[2], hh[3]};
}
__device__ __forceinline__ void chain(LAS unsigned char* lds, const Args& a, int b, int h, int dir) {
    const int tid = threadIdx.x, lane = tid & 63, wave = __builtin_amdgcn_readfirstlane(tid >> 6), r32 = lane & 31, hi = lane >> 5;
    const bf16_t* Z = (const bf16_t*)(a.ws + WS_Z); const float* tab = (const float*)(a.ws + WS_TAB); bf16_t* O = (bf16_t*)(a.ws + (dir ? WS_OB : WS_OF));
    const int k0 = 2 * lane, i0 = 8 * wave;
    const float lb0 = tab[dir * 1024 + h * 128 + k0], lb1 = tab[dir * 1024 + h * 128 + k0 + 1];
    const int cq = C_HQ + h * 128 + k0, cf = (dir ? C_FB : C_FF) + h * 128 + k0, cv = C_HV + h * 128 + k0;
    const int tt = wave & 1, vt = wave >> 1, kt = wave & 3, vtp = wave >> 2;
    f32x16 Sacc[2]; Sacc[0] = f32x16{}; Sacc[1] = f32x16{};
    for (int i = tid; i < 4 * 128 * 64 / 4; i += NTHR) ((LAS unsigned*)(lds + L_S))[i] = 0u;
    unsigned zq[8], zf[8], zv[8];
#define HG_TOK(n, i) ((size_t)(b * SEQ + (dir ? (SEQ - 1 - (64 * (n) + (i))) : (64 * (n) + (i)))) * INW)
#define HG_LOAD(n) do { _Pragma("unroll") for (int i = 0; i < 8; ++i) { const bf16_t* zr = Z + HG_TOK(n, i0 + i); zq[i] = *(const unsigned*)(zr + cq); zf[i] = *(const unsigned*)(zr + cf); zv[i] = *(const unsigned*)(zr + cv); } } while (0)
    HG_LOAD(0);
    for (int n = 0; n < SEQ / 64; ++n) {
        float f0[8], f1[8], p0[8], p1[8]; float run0 = 0.f, run1 = 0.f;
#pragma unroll
        for (int i = 0; i < 8; ++i) { const float z0 = __uint_as_float(zf[i] << 16), z1 = __uint_as_float(zf[i] & 0xffff0000u);
            f0[i] = lb0 + (1.f - lb0) * sigmoidf_(z0); f1[i] = lb1 + (1.f - lb1) * sigmoidf_(z1);
            run0 += __logf(f0[i]); run1 += __logf(f1[i]); p0[i] = run0; p1[i] = run1; }
        *(LAS f32x2v*)(lds + L_TOT + (wave * 128 + k0) * 4) = (f32x2v){run0, run1};
        __syncthreads();
#pragma unroll
        for (int j = 0; j < 2; ++j)
#pragma unroll
            for (int r = 0; r < 16; ++r) *(LAS bf16_t*)(lds + L_S + ((2 * vtp + j) * 128 + 32 * kt + crow(r, hi)) * 64 + r32 * 2) = (bf16_t)f2bf(Sacc[j][r]);
        float off0 = 0.f, off1 = 0.f;
        for (int w = 0; w < wave; ++w) { const f32x2v t2 = *(const LAS f32x2v*)(lds + L_TOT + (w * 128 + k0) * 4); off0 += t2.x; off1 += t2.y; }
#pragma unroll
        for (int i = 0; i < 8; ++i) { const int row = i0 + i;
            const float b0 = off0 + p0[i], b1 = off1 + p1[i], e0 = __expf(b0), e1 = __expf(b1), ie0 = __expf(-b0), ie1 = __expf(-b1);
            const float q0 = siluf_(__uint_as_float(zq[i] << 16)), q1 = siluf_(__uint_as_float(zq[i] & 0xffff0000u));
            *(LAS unsigned*)(lds + L_QT + row * QS + k0 * 2) = pk2(q0 * e0, q1 * e1);
            const unsigned kk = pk2((1.f - f0[i]) * ie0, (1.f - f1[i]) * ie1);
            *(LAS unsigned*)(lds + L_KT1 + row * QS + k0 * 2) = kk; *(LAS unsigned*)(lds + L_KT2 + row * K2S + k0 * 2) = kk;
            *(LAS unsigned*)(lds + L_V + ((k0 >> 5) * 64 + row) * 64 + (k0 & 31) * 2) = zv[i];
            if (row == 63) *(LAS f32x2v*)(lds + L_EL + k0 * 4) = (f32x2v){e0, e1}; }
        __syncthreads();
        if (n + 1 < SEQ / 64) HG_LOAD(n + 1);
        bf16x8 qf[8];
        { const LAS unsigned char* qp = lds + L_QT + (32 * tt + r32) * QS + 16 * hi;
#pragma unroll
          for (int kk = 0; kk < 8; ++kk) qf[kk] = *(const LAS bf16x8*)(qp + 32 * kk); }
        f32x16 o = f32x16{};
#pragma unroll
        for (int st = 0; st < 2; ++st) if (st <= tt) {
            f32x16 acc = f32x16{}; const LAS unsigned char* kp = lds + L_KT1 + (32 * st + r32) * QS + 16 * hi;
#pragma unroll
            for (int kk = 0; kk < 8; ++kk) { const bf16x8 kf = *(const LAS bf16x8*)(kp + 32 * kk); acc = __builtin_amdgcn_mfma_f32_32x32x16_bf16(kf, qf[kk], acc, 0, 0, 0); }
            if (st == tt) {
#pragma unroll
                for (int r = 0; r < 16; ++r) acc[r] = (crow(r, hi) <= r32) ? acc[r] : 0.f; }
#pragma unroll
            for (int s2 = 0; s2 < 2; ++s2) { typedef unsigned u32x4 __attribute__((ext_vector_type(4)));
                u32x4 pw; pw.x = cvtpk(acc[8 * s2 + 0], acc[8 * s2 + 1]); pw.y = cvtpk(acc[8 * s2 + 2], acc[8 * s2 + 3]); pw.z = cvtpk(acc[8 * s2 + 4], acc[8 * s2 + 5]); pw.w = cvtpk(acc[8 * s2 + 6], acc[8 * s2 + 7]);
                const bf16x8 vf = frag_tr_perm(lds + L_V + vt * 4096, 64, 32 * st + 16 * s2, 0, lane);
                o = __builtin_amdgcn_mfma_f32_32x32x16_bf16(__builtin_bit_cast(bf16x8, pw), vf, o, 0, 0, 0); } }
#pragma unroll
        for (int kk = 0; kk < 8; ++kk) { const bf16x8 sf = frag_tr_nat(lds + L_S + vt * 8192, 64, 16 * kk, 0, lane); o = __builtin_amdgcn_mfma_f32_32x32x16_bf16(qf[kk], sf, o, 0, 0, 0); }
#pragma unroll
        for (int r = 0; r < 16; ++r) { const int t = 32 * tt + crow(r, hi);
            O[(size_t)(b * SEQ + (dir ? (SEQ - 1 - (64 * n + t)) : (64 * n + t))) * 1024 + h * 128 + 32 * vt + r32] = (bf16_t)f2bf(o[r]); }
#pragma unroll
        for (int s4 = 0; s4 < 4; ++s4) { const bf16x8 af = frag_tr_nat(lds + L_KT2, K2S, 16 * s4, 32 * kt, lane);
#pragma unroll
            for (int j = 0; j < 2; ++j) { const bf16x8 vf = frag_tr_nat(lds + L_V + (2 * vtp + j) * 4096, 64, 16 * s4, 0, lane); Sacc[j] = __builtin_amdgcn_mfma_f32_32x32x16_bf16(af, vf, Sacc[j], 0, 0, 0); } }
#pragma unroll
        for (int r = 0; r < 16; ++r) { const float el = *(const LAS float*)(lds + L_EL + (32 * kt + crow(r, hi)) * 4); Sacc[0][r] *= el; Sacc[1][r] *= el; }
    }
    __syncthreads();
#undef HG_TOK
#undef HG_LOAD
}
}
__device__ __forceinline__ void ph_rope(const Args& a) {
    bf16_t* Z = (bf16_t*)(a.ws + WS_Z); const float* tab = (const float*)(a.ws + WS_TAB); const float* ct = tab + 16384; const float* st = ct + T * 8;
    const size_t n = (size_t)T * 2 * 16 * 8;
    for (size_t i = (size_t)blockIdx.x * NTHR + threadIdx.x; i < n; i += (size_t)gridDim.x * NTHR) {
        const int j = i & 7, h = (i >> 3) & 15, qk = (i >> 7) & 1; const int m = (int)(i >> 8);
        bf16_t* p = Z + (size_t)m * INW + (qk ? C_K : C_Q) + h * 64 + j;
        const float x1 = bf2f(p[0]), x2 = bf2f(p[8]), c = ct[m * 8 + j], s = st[m * 8 + j];
        p[0] = (bf16_t)f2bf(x1 * c - x2 * s); p[8] = (bf16_t)f2bf(x2 * c + x1 * s);
    }
}
__device__ __forceinline__ void ph_hgrn_naive(const Args& a, LAS unsigned char* lds) {
    if (blockIdx.x >= 64) return;
    const bf16_t* Z = (const bf16_t*)(a.ws + WS_Z); const float* tab = (const float*)(a.ws + WS_TAB);
    LAS float* qs = (LAS float*)lds; LAS float* fs = qs + 16 * 128; LAS float* vs = fs + 16 * 128;
    const int dir = blockIdx.x & 1, h = (blockIdx.x >> 1) & 7, b = blockIdx.x >> 4, v = threadIdx.x & 127; const bool act = threadIdx.x < 128;
    const float lb = tab[dir * 1024 + h * 128 + v];
    float S[128];
#pragma unroll
    for (int k = 0; k < 128; ++k) S[k] = 0.f;
    bf16_t* O = (bf16_t*)(a.ws + (dir ? WS_OB : WS_OF));
    for (int c0 = 0; c0 < SEQ; c0 += 16) {
        __syncthreads();
        if (act) for (int tt = 0; tt < 16; ++tt) { const int s = dir ? (SEQ - 1 - (c0 + tt)) : (c0 + tt); const bf16_t* zr = Z + (size_t)(b * SEQ + s) * INW;
            qs[tt * 128 + v] = siluf_(bf2f(zr[C_HQ + h * 128 + v]));
            fs[tt * 128 + v] = lb + (1.f - lb) * sigmoidf_(bf2f(zr[(dir ? C_FB : C_FF) + h * 128 + v]));
            vs[tt * 128 + v] = bf2f(zr[C_HV + h * 128 + v]); }
        __syncthreads();
        if (act) for (int tt = 0; tt < 16; ++tt) { const float vv = vs[tt * 128 + v]; float o = 0.f;
#pragma unroll
            for (int k = 0; k < 128; ++k) { const float f = fs[tt * 128 + k]; S[k] = f * S[k] + (1.f - f) * vv; o += S[k] * qs[tt * 128 + k]; }
            const int s = dir ? (SEQ - 1 - (c0 + tt)) : (c0 + tt);
            O[(size_t)(b * SEQ + s) * 1024 + h * 128 + v] = (bf16_t)f2bf(o); }
    }
}
__device__ __forceinline__ void ph_combine(const Args& a) {
    typedef unsigned short us16 __attribute__((ext_vector_type(16)));
    const bf16_t* Z = (const bf16_t*)(a.ws + WS_Z); const bf16_t* OF = (const bf16_t*)(a.ws + WS_OF); const bf16_t* OB = (const bf16_t*)(a.ws + WS_OB);
    const bf16_t* OG2 = (const bf16_t*)(a.ws + WS_OG2); const float* LSE = (const float*)(a.ws + WS_LSE); bf16_t* Y = (bf16_t*)(a.ws + WS_R1);
    const int lane = threadIdx.x & 63, gw = blockIdx.x * NWAVES + (threadIdx.x >> 6), nw = gridDim.x * NWAVES;
    float gh[16];
#pragma unroll
    for (int i = 0; i < 16; ++i) gh[i] = a.g_hg[(lane & 7) * 16 + i];
    for (int m = gw; m < T; m += nw) {
        bf16_t* yr = Y + (size_t)m * DM; const bf16_t* zr = Z + (size_t)m * INW;
        const us16 o0 = *(const us16*)(yr + lane * 16), o1 = *(const us16*)(yr + 1024 + lane * 16), o2 = *(const us16*)(OG2 + (size_t)m * 1024 + lane * 16);
        const us16 ga = *(const us16*)(zr + C_AG + lane * 16), gg = *(const us16*)(zr + C_HG + lane * 16);
        const us16 f = *(const us16*)(OF + (size_t)m * 1024 + lane * 16), bw = *(const us16*)(OB + (size_t)m * 1024 + lane * 16);
        const int h = lane >> 2;
        const float l0 = LSE[(size_t)m * 16 + h], l1 = LSE[(size_t)(T + m) * 16 + h], l2 = LSE[(size_t)(2 * T + m) * 16 + h];
        const float mx = fmaxf(l0, fmaxf(l1, l2)); float w0 = __expf(l0 - mx), w1 = __expf(l1 - mx), w2 = __expf(l2 - mx); const float iw = 1.f / (w0 + w1 + w2); w0 *= iw; w1 *= iw; w2 *= iw;
        float s[16], ss = 0.f;
#pragma unroll
        for (int i = 0; i < 16; ++i) { s[i] = bf2f(f[i]) + bf2f(bw[i]); ss += s[i] * s[i]; }
        ss += __shfl_xor(ss, 1); ss += __shfl_xor(ss, 2); ss += __shfl_xor(ss, 4);
        const float rr = rsqrtf(ss * (1.f / 128.f) + EPS);
        unsigned ya[8], yh[8];
#pragma unroll
        for (int i = 0; i < 8; ++i) {
            const float e0 = (w0 * bf2f(o0[2 * i]) + w1 * bf2f(o1[2 * i]) + w2 * bf2f(o2[2 * i])) * siluf_(bf2f(ga[2 * i]));
            const float e1 = (w0 * bf2f(o0[2 * i + 1]) + w1 * bf2f(o1[2 * i + 1]) + w2 * bf2f(o2[2 * i + 1])) * siluf_(bf2f(ga[2 * i + 1]));
            ya[i] = pk2(e0, e1);
            yh[i] = pk2(s[2 * i] * rr * gh[2 * i] * siluf_(bf2f(gg[2 * i])), s[2 * i + 1] * rr * gh[2 * i + 1] * siluf_(bf2f(gg[2 * i + 1]))); }
        v4u* ya4 = (v4u*)(yr + lane * 16); v4u* yh4 = (v4u*)(yr + 1024 + lane * 16);
        ya4[0] = (v4u){ya[0], ya[1], ya[2], ya[3]}; ya4[1] = (v4u){ya[4], ya[5], ya[6], ya[7]};
        yh4[0] = (v4u){yh[0], yh[1], yh[2], yh[3]}; yh4[1] = (v4u){yh[4], yh[5], yh[6], yh[7]};
    }
}
__device__ __forceinline__ void ph_h1(const Args& a) {
    const float* y2 = (const float*)(a.ws + WS_Z); bf16_t* h1b = (bf16_t*)(a.ws + WS_R1);
    const int lane = threadIdx.x & 63, gw = blockIdx.x * NWAVES + (threadIdx.x >> 6), nw = gridDim.x * NWAVES;
    for (int m = gw; m < T; m += nw) {
        const float4* yr = (const float4*)(y2 + (size_t)m * DM); float4 v[8]; float s = 0.f;
#pragma unroll
        for (int j = 0; j < 8; ++j) { v[j] = yr[lane + 64 * j]; s += v[j].x * v[j].x + v[j].y * v[j].y + v[j].z * v[j].z + v[j].w * v[j].w; }
        const float r = rsqrtf(wave_sum(s) * (1.f / DM) + EPS);
#pragma unroll
        for (int j = 0; j < 8; ++j) { const int c4 = lane + 64 * j; const float4 gg = ((const float4*)a.g_post)[c4], xx = ((const float4*)(a.x + (size_t)m * DM))[c4];
            float4 hh; hh.x = xx.x + v[j].x * r * gg.x; hh.y = xx.y + v[j].y * r * gg.y; hh.z = xx.z + v[j].z * r * gg.z; hh.w = xx.w + v[j].w * r * gg.w;
            ((float4*)(a.out + (size_t)m * DM))[c4] = hh; uint2 o; o.x = pk2(hh.x, hh.y); o.y = pk2(hh.z, hh.w); *(uint2*)(h1b + (size_t)m * DM + c4 * 4) = o; }
    }
}
__device__ __forceinline__ void ph_final(const Args& a) {
    const float* G = (const float*)(a.ws + WS_Z); const float* E = (const float*)(a.ws + WS_Z + 128 * MiB);
    const int lane = threadIdx.x & 63, gw = blockIdx.x * NWAVES + (threadIdx.x >> 6), nw = gridDim.x * NWAVES;
    for (int m = gw; m < T; m += nw) {
        float4 v[8]; float s = 0.f;
#pragma unroll
        for (int j = 0; j < 8; ++j) { const float4 g = ((const float4*)(G + (size_t)m * DM))[lane + 64 * j], e = ((const float4*)(E + (size_t)m * DM))[lane + 64 * j];
            v[j].x = sigmoidf_(g.x) * e.x; v[j].y = sigmoidf_(g.y) * e.y; v[j].z = sigmoidf_(g.z) * e.z; v[j].w = sigmoidf_(g.w) * e.w;
            s += v[j].x * v[j].x + v[j].y * v[j].y + v[j].z * v[j].z + v[j].w * v[j].w; }
        const float r = rsqrtf(wave_sum(s) * (1.f / DM) + EPS);
#pragma unroll
        for (int j = 0; j < 8; ++j) { const int c4 = lane + 64 * j; const float4 gg = ((const float4*)a.g_ple)[c4]; float4 hh = ((float4*)(a.out + (size_t)m * DM))[c4];
            hh.x += v[j].x * r * gg.x; hh.y += v[j].y * r * gg.y; hh.z += v[j].z * r * gg.z; hh.w += v[j].w * r * gg.w; ((float4*)(a.out + (size_t)m * DM))[c4] = hh; }
    }
}
__global__ void __launch_bounds__(NTHR, 2) mega_fwd(Args a) {
    extern __shared__ __attribute__((aligned(16))) unsigned char lds_raw[];
    LAS unsigned char* lds = (LAS unsigned char*)lds_raw;
    cg::grid_group grid = cg::this_grid();
    unsigned char* ws = a.ws;
    const int lo = a.ph_lo, hi = a.ph_hi;
#define IN(k) (lo <= (k) && (k) < hi)
#define SEAM(k) do { if (IN(k) && IN((k) + 1)) grid.sync(); } while (0)
    if (IN(0)) { p0_prologue(a, lds); __syncthreads(); }
    SEAM(0);
    if (IN(1)) { pg8::Gemm g{(const bf16_t*)(ws + WS_R1), (const bf16_t*)(ws + WS_WIN), T, INW, DM}; pg8::StaticOrder S; S.init(T, INW, gridDim.x, blockIdx.x);
        pg8::EpiBf16<0> E{(bf16_t*)(ws + WS_Z), INW, nullptr, 0, 0, 1.f};
        pg8::gemm_phase<pg8::EpiBf16<0>, pg8::StaticOrder, true, true>(lds, g, S, E); }
    SEAM(1);
    if (IN(2)) ph_rope(a);
    SEAM(2);
    if (IN(3)) { if (blockIdx.x < 64) hg::chain(lds, a, (int)blockIdx.x >> 4, ((int)blockIdx.x >> 1) & 7, (int)blockIdx.x & 1); else att::attn_phase(lds, a, (int)(blockIdx.x >> 3) - 8, (int)(gridDim.x >> 3) - 8); }
    SEAM(3);
    if (IN(4)) ph_combine(a);
    SEAM(4);
    if (IN(5)) { pg8::Gemm g{(const bf16_t*)(ws + WS_R1), (const bf16_t*)(ws + WS_WOUT), T, DM, DM}; pg8::StaticOrder S; S.init(T, DM, gridDim.x, blockIdx.x);
        pg8::EpiF32 E{(float*)(ws + WS_Z), DM};
        pg8::gemm_phase<pg8::EpiF32, pg8::StaticOrder, true, true>(lds, g, S, E); }
    SEAM(5);
    if (IN(6)) { p_late_convert(a, lds); ph_h1(a); }
    SEAM(6);
    if (IN(7)) {
        { pg8::Gemm g{(const bf16_t*)(ws + WS_R1), (const bf16_t*)(ws + WS_WPG), T, DM, DM}; pg8::StaticOrder S; S.init(T, DM, gridDim.x, blockIdx.x);
          pg8::EpiF32 E{(float*)(ws + WS_Z), DM};
          pg8::gemm_phase<pg8::EpiF32, pg8::StaticOrder, true, true>(lds, g, S, E); }
        __syncthreads();
        { pg8::Gemm g{(const bf16_t*)(ws + WS_PB), (const bf16_t*)(ws + WS_WPP), T, DM, PLE}; pg8::StaticOrder S; S.init(T, DM, gridDim.x, blockIdx.x);
          pg8::EpiF32 E{(float*)(ws + WS_Z + 128 * MiB), DM};
          pg8::gemm_phase<pg8::EpiF32, pg8::StaticOrder, true, true>(lds, g, S, E); }
    }
    SEAM(7);
    if (IN(8)) ph_final(a);
#undef IN
#undef SEAM
}
constexpr int N_PHASES = 9;
#ifndef MK_SPLIT
#define MK_SPLIT 0
#endif
extern "C" void kernel_launch(void* const* d_in, const int* in_sizes, int n_in, void* d_out, int out_size, void* d_ws, size_t ws_size, hipStream_t stream) {
    static int grid = 0;
    if (grid == 0) {
        if (n_in != 13 || in_sizes[0] != T * DM || out_size != T * DM || ws_size < WS_END) { fprintf(stderr, "kernel_launch: unexpected shapes n_in %d in0 %d out %d ws %zu (need %zu)\n", n_in, n_in > 0 ? in_sizes[0] : -1, out_size, ws_size, (size_t)WS_END); grid = -1; return; }
        int dev = 0, cus = 0, per_cu = 0;
        if (hipGetDevice(&dev) != hipSuccess || hipDeviceGetAttribute(&cus, hipDeviceAttributeMultiprocessorCount, dev) != hipSuccess) { grid = -1; return; }
        if (hipFuncSetAttribute((const void*)mega_fwd, hipFuncAttributeMaxDynamicSharedMemorySize, LDS_BYTES) != hipSuccess) { fprintf(stderr, "kernel_launch: hipFuncSetAttribute failed\n"); grid = -1; return; }
        if (hipOccupancyMaxActiveBlocksPerMultiprocessor(&per_cu, (const void*)mega_fwd, NTHR, LDS_BYTES) != hipSuccess || per_cu < 1) { fprintf(stderr, "kernel_launch: occupancy query says %d blocks per CU\n", per_cu); (void)hipGetLastError(); grid = -1; return; }
        grid = cus * (per_cu > 1 ? 1 : per_cu);
        fprintf(stderr, "kernel_launch: %d CUs, %d blocks/CU admitted, grid %d, ws %zu\n", cus, per_cu, grid, ws_size);
    }
    if (grid < 0) return;
    Args a{};
    a.x = (const float*)d_in[0]; a.p = (const float*)d_in[1]; a.pos = (const int*)d_in[2]; a.w_in = (const float*)d_in[3]; a.w_out = (const float*)d_in[4];
    a.g_pre = (const float*)d_in[5]; a.g_post = (const float*)d_in[6]; a.g_hg = (const float*)d_in[7]; a.lb_fwd = (const float*)d_in[8]; a.lb_bwd = (const float*)d_in[9];
    a.w_pg = (const float*)d_in[10]; a.w_pp = (const float*)d_in[11]; a.g_ple = (const float*)d_in[12]; a.out = (float*)d_out; a.ws = (unsigned char*)d_ws;
    const int nl = MK_SPLIT ? N_PHASES : 1;
    for (int li = 0; li < nl; ++li) {
        a.ph_lo = MK_SPLIT ? li : 0; a.ph_hi = MK_SPLIT ? li + 1 : N_PHASES;
        void* args[] = {&a};
        hipError_t e = hipLaunchCooperativeKernel((const void*)mega_fwd, dim3(grid), dim3(NTHR), args, LDS_BYTES, stream);
        if (e != hipSuccess) { fprintf(stderr, "kernel_launch: cooperative launch failed: %s (grid %d)\n", hipGetErrorString(e), grid); break; }
    }
}
```
